# Optimizing an MI355X kernel written in HIP

```python
import jax, jax.numpy as jnp
from jax import lax
import numpy as np

D_MODEL = 2048
BATCH = 8
SEQ = 2048
DEPTH = 1
DEC_BATCH = 8
DEC_SEQ = 64
PAST_LEN = 1024

CHUNK = 64
Q_BLOCK = 128
FOX_HEADS = 12
FOX_HEAD_DIM = 128
FOX_WIDTH = FOX_HEADS * FOX_HEAD_DIM
CONV_WIDTH = 1536
CONV_K = 3
MEM_TOKENS = 256
MEM_HEADS = 4
MEM_HEAD_DIM = 256
MEM_WIDTH = MEM_HEADS * MEM_HEAD_DIM
N_BRANCH = 3
LN_EPS = 1e-5
NEG_INF = -1e30
DN_ALPHA = (2 * DEPTH) ** 0.25
DN_BETA = (8 * DEPTH) ** -0.25
IN_SIZES = (FOX_WIDTH, FOX_WIDTH, FOX_WIDTH, FOX_HEADS, FOX_WIDTH,
            CONV_WIDTH, CONV_WIDTH, CONV_WIDTH, CONV_WIDTH, MEM_WIDTH, MEM_WIDTH)
IN_WIDTH = 4 * FOX_WIDTH + FOX_HEADS + 4 * CONV_WIDTH + 2 * MEM_WIDTH

kernel_name = "fox_shortconv_memxattn_gated_hybrid_step"


def _layernorm(x, g, b):
    xf = x.astype(jnp.float32)
    mu = jnp.mean(xf, axis=-1, keepdims=True)
    var = jnp.mean(jnp.square(xf - mu), axis=-1, keepdims=True)
    y = (xf - mu) * lax.rsqrt(var + LN_EPS) * g.astype(jnp.float32) + b.astype(jnp.float32)
    return y.astype(x.dtype)


def _project(x, w_in, fox_bf):
    B, T, _ = x.shape
    z = jnp.einsum('btd,dn->btn', x, w_in)
    offs = tuple(int(o) for o in np.cumsum(IN_SIZES)[:-1])
    q, k, v, f, g_fox, b_gate, c_gate, h_in, g_conv, mq, g_mem = jnp.split(z, offs, axis=-1)
    q = q.reshape(B, T, FOX_HEADS, FOX_HEAD_DIM)
    k = k.reshape(B, T, FOX_HEADS, FOX_HEAD_DIM)
    v = v.reshape(B, T, FOX_HEADS, FOX_HEAD_DIM)
    logf = jax.nn.log_sigmoid(f.astype(jnp.float32) + fox_bf.astype(jnp.float32))
    u = c_gate * h_in
    mq = mq.reshape(B, T, MEM_HEADS, MEM_HEAD_DIM)
    return q, k, v, logf, g_fox, b_gate, u, g_conv, mq, g_mem


def _fox_prompt(q, k, v, logf):
    B, S, H, Dh = q.shape
    nb = S // Q_BLOCK
    scale = Dh ** -0.5
    cum = jnp.transpose(jnp.cumsum(logf, axis=1), (0, 2, 1))
    k_pos = jnp.arange(S)
    qb = jnp.moveaxis(q.reshape(B, nb, Q_BLOCK, H, Dh), 1, 0)
    cb = jnp.moveaxis(cum.reshape(B, H, nb, Q_BLOCK), 2, 0)
    pb = k_pos.reshape(nb, Q_BLOCK)

    def block(args):
        qi, ci, pi = args
        s = jnp.einsum('bqhd,bkhd->bhqk', qi, k).astype(jnp.float32) * scale
        s = s + ci[..., :, None] - cum[:, :, None, :]
        s = jnp.where(k_pos[None, :] <= pi[:, None], s, NEG_INF)
        p = jax.nn.softmax(s, axis=-1).astype(v.dtype)
        return jnp.einsum('bhqk,bkhd->bqhd', p, v)

    o = lax.map(block, (qb, cb, pb))
    return jnp.moveaxis(o, 0, 1).reshape(B, S, H * Dh)


def _fox_sample(q, k_new, v_new, logf_new, k_cache, v_cache, logf_cache):
    B, T, H, Dh = q.shape
    P = k_cache.shape[1]
    scale = Dh ** -0.5
    k = jnp.concatenate([k_cache.astype(k_new.dtype), k_new], axis=1)
    v = jnp.concatenate([v_cache.astype(v_new.dtype), v_new], axis=1)
    logf = jnp.concatenate([logf_cache.astype(jnp.float32), logf_new], axis=1)
    cum = jnp.transpose(jnp.cumsum(logf, axis=1), (0, 2, 1))
    s = jnp.einsum('bqhd,bkhd->bhqk', q, k).astype(jnp.float32) * scale
    s = s + cum[:, :, P:, None] - cum[:, :, None, :]
    mask = jnp.arange(P + T)[None, :] <= (P + jnp.arange(T))[:, None]
    s = jnp.where(mask, s, NEG_INF)
    p = jax.nn.softmax(s, axis=-1).astype(v.dtype)
    return jnp.einsum('bhqk,bkhd->bqhd', p, v).reshape(B, T, H * Dh)


def _short_conv(u, prev, w, b):
    T = u.shape[1]
    up = jnp.concatenate([prev.astype(u.dtype), u], axis=1)
    y = sum(w[j] * up[:, j:j + T] for j in range(CONV_K)) + b
    return y, up[:, T:]


def _mem_kv(mem, w_mem_kv):
    B, M, _ = mem.shape
    kv = jnp.einsum('bmd,dn->bmn', mem, w_mem_kv)
    mk, mv = jnp.split(kv, 2, axis=-1)
    return mk.reshape(B, M, MEM_HEADS, MEM_HEAD_DIM), mv.reshape(B, M, MEM_HEADS, MEM_HEAD_DIM)


def _mem_attn(q, mk, mv):
    B, T, _, _ = q.shape
    s = jnp.einsum('bthd,bmhd->bhtm', q, mk.astype(q.dtype)).astype(jnp.float32) * (MEM_HEAD_DIM ** -0.5)
    p = jax.nn.softmax(s, axis=-1).astype(q.dtype)
    return jnp.einsum('bhtm,bmhd->bthd', p, mv.astype(q.dtype)).reshape(B, T, MEM_WIDTH)


def _combine(x, o_fox, g_fox, o_conv, g_conv, o_mem, g_mem,
             w_fox_out, w_conv_out, w_mem_out, w_merge, b_merge, w_o, ln_g, ln_b):
    y_fox = jnp.einsum('btc,cd->btd', o_fox * jax.nn.silu(g_fox), w_fox_out)
    y_conv = jnp.einsum('btc,cd->btd', o_conv * jax.nn.silu(g_conv), w_conv_out)
    y_mem = jnp.einsum('btc,cd->btd', o_mem * jax.nn.silu(g_mem), w_mem_out)
    gates = jax.nn.sigmoid(jnp.einsum('btd,dn->btn', x, w_merge) + b_merge)
    g1, g2, g3 = jnp.split(gates, N_BRANCH, axis=-1)
    m = g1 * y_fox + g2 * y_conv + g3 * y_mem
    h = jnp.einsum('btd,de->bte', m, w_o)
    return _layernorm(DN_ALPHA * x + h, ln_g, ln_b)


def setup_inputs(seed: int = 0) -> dict:
    key = jax.random.key(seed)
    ks = jax.random.split(key, 24)
    f32 = jnp.float32
    L = DEPTH

    def nrm(k, shape, scale):
        return jax.random.normal(k, shape, f32) * scale

    return {
        "x_prompt": nrm(ks[0], (BATCH, SEQ, D_MODEL), 1.0),
        "x_sample": nrm(ks[1], (DEC_BATCH, DEC_SEQ, D_MODEL), 1.0),
        "mem_prompt": nrm(ks[2], (BATCH, MEM_TOKENS, D_MODEL), 1.0),
        "cache_fox_k": nrm(ks[3], (L, DEC_BATCH, PAST_LEN, FOX_HEADS, FOX_HEAD_DIM), 1.0),
        "cache_fox_v": nrm(ks[4], (L, DEC_BATCH, PAST_LEN, FOX_HEADS, FOX_HEAD_DIM), 1.0),
        "cache_fox_logf": jax.nn.log_sigmoid(nrm(ks[5], (L, DEC_BATCH, PAST_LEN, FOX_HEADS), 1.0) + 3.0),
        "state_conv": nrm(ks[6], (L, DEC_BATCH, CONV_K - 1, CONV_WIDTH), 1.0),
        "cache_mem_k": nrm(ks[7], (L, DEC_BATCH, MEM_TOKENS, MEM_HEADS, MEM_HEAD_DIM), 1.0),
        "cache_mem_v": nrm(ks[8], (L, DEC_BATCH, MEM_TOKENS, MEM_HEADS, MEM_HEAD_DIM), 1.0),
        "w_in": nrm(ks[9], (L, D_MODEL, IN_WIDTH), D_MODEL ** -0.5),
        "fox_bf": jnp.linspace(1.0, 4.0, FOX_HEADS)[None, :] + nrm(ks[10], (L, FOX_HEADS), 0.1),
        "conv_w": nrm(ks[11], (L, CONV_K, CONV_WIDTH), CONV_K ** -0.5),
        "conv_b": nrm(ks[12], (L, CONV_WIDTH), 0.01),
        "w_mem_kv": nrm(ks[13], (L, D_MODEL, 2 * MEM_WIDTH), D_MODEL ** -0.5),
        "w_fox_out": nrm(ks[14], (L, FOX_WIDTH, D_MODEL), FOX_WIDTH ** -0.5 * DN_BETA),
        "w_conv_out": nrm(ks[15], (L, CONV_WIDTH, D_MODEL), CONV_WIDTH ** -0.5 * DN_BETA),
        "w_mem_out": nrm(ks[16], (L, MEM_WIDTH, D_MODEL), MEM_WIDTH ** -0.5 * DN_BETA),
        "w_merge": nrm(ks[17], (L, D_MODEL, N_BRANCH * D_MODEL), D_MODEL ** -0.5),
        "b_merge": nrm(ks[18], (L, N_BRANCH * D_MODEL), 0.01),
        "w_o": nrm(ks[19], (L, D_MODEL, D_MODEL), D_MODEL ** -0.5 * DN_BETA),
        "ln_g": 1.0 + nrm(ks[20], (L, D_MODEL), 0.01),
        "ln_b": nrm(ks[21], (L, D_MODEL), 0.01),
    }


def reference(x_prompt, x_sample, mem_prompt, cache_fox_k, cache_fox_v, cache_fox_logf, state_conv,
              cache_mem_k, cache_mem_v, w_in, fox_bf, conv_w, conv_b, w_mem_kv, w_fox_out, w_conv_out,
              w_mem_out, w_merge, b_merge, w_o, ln_g, ln_b):
    hp, hs = x_prompt, x_sample
    fk_p, fv_p, fl_p, cv_p, mk_p, mv_p = [], [], [], [], [], []
    fk_s, fv_s, fl_s, cv_s = [], [], [], []
    for l in range(DEPTH):
        q, k, v, logf, g_fox, b_gate, u, g_conv, mq, g_mem = _project(hp, w_in[l], fox_bf[l])
        o_fox = _fox_prompt(q, k, v, logf)
        prev0 = jnp.zeros((hp.shape[0], CONV_K - 1, CONV_WIDTH), hp.dtype)
        c, tail = _short_conv(u, prev0, conv_w[l], conv_b[l])
        mk, mv = _mem_kv(mem_prompt, w_mem_kv[l])
        o_mem = _mem_attn(mq, mk, mv)
        hp_next = _combine(hp, o_fox, g_fox, b_gate * c, g_conv, o_mem, g_mem,
                           w_fox_out[l], w_conv_out[l], w_mem_out[l], w_merge[l], b_merge[l], w_o[l],
                           ln_g[l], ln_b[l])
        fk_p.append(k); fv_p.append(v); fl_p.append(logf); cv_p.append(tail)
        mk_p.append(mk); mv_p.append(mv)
        hp = hp_next
        q, k, v, logf, g_fox, b_gate, u, g_conv, mq, g_mem = _project(hs, w_in[l], fox_bf[l])
        o_fox = _fox_sample(q, k, v, logf, cache_fox_k[l], cache_fox_v[l], cache_fox_logf[l])
        c, tail = _short_conv(u, state_conv[l], conv_w[l], conv_b[l])
        o_mem = _mem_attn(mq, cache_mem_k[l], cache_mem_v[l])
        hs_next = _combine(hs, o_fox, g_fox, b_gate * c, g_conv, o_mem, g_mem,
                           w_fox_out[l], w_conv_out[l], w_mem_out[l], w_merge[l], b_merge[l], w_o[l],
                           ln_g[l], ln_b[l])
        fk_s.append(k); fv_s.append(v); fl_s.append(logf); cv_s.append(tail)
        hs = hs_next
    return (hp, hs,
            jnp.stack(fk_p), jnp.stack(fv_p), jnp.stack(fl_p), jnp.stack(cv_p),
            jnp.stack(mk_p), jnp.stack(mv_p),
            jnp.stack(fk_s), jnp.stack(fv_s), jnp.stack(fl_s), jnp.stack(cv_s))
```

```cpp
#include <hip/hip_runtime.h>
#include <hip/hip_cooperative_groups.h>
#include <cstdio>
#include <cstdint>
namespace cg = cooperative_groups;

#define LAS __attribute__((address_space(3)))
typedef unsigned short bf16_t;
typedef short bf16x8 __attribute__((ext_vector_type(8)));
typedef short s16x4 __attribute__((ext_vector_type(4)));
typedef float f32x4 __attribute__((ext_vector_type(4)));
typedef float f32x16 __attribute__((ext_vector_type(16)));
typedef unsigned u32x4 __attribute__((ext_vector_type(4)));
typedef unsigned u32x2 __attribute__((ext_vector_type(2)));

constexpr int DM = 2048, MP = 16384, MS = 512, MM = 2048, SEQ = 2048, DECS = 64, PAST = 1024, NBATCH = 8;
constexpr int FW = 1536, MW = 1024, INW = 14348, NH = 12, SKVS = PAST + DECS;
constexpr int MROWS = MP + MS;
constexpr int NPAN = MROWS / 256;
constexpr int NTA = 57;
constexpr size_t O_YP = 0, O_YS = O_YP + (size_t)MP * DM, O_FKP = O_YS + (size_t)MS * DM, O_FVP = O_FKP + (size_t)MP * FW,
                 O_FLP = O_FVP + (size_t)MP * FW, O_CVP = O_FLP + (size_t)MP * NH, O_MKP = O_CVP + (size_t)NBATCH * 2 * FW,
                 O_MVP = O_MKP + (size_t)MM * MW, O_FKS = O_MVP + (size_t)MM * MW, O_FVS = O_FKS + (size_t)MS * FW,
                 O_FLS = O_FVS + (size_t)MS * FW, O_CVS = O_FLS + (size_t)MS * NH, O_END = O_CVS + (size_t)NBATCH * 2 * FW;
constexpr size_t Y_KS = 0, Y_VS = Y_KS + (size_t)NBATCH * SKVS * FW * 2, Y_MQ = Y_VS + (size_t)NBATCH * SKVS * FW * 2,
                 Y_SGM = Y_MQ + (size_t)MROWS * MW * 2, Y_MKB = Y_SGM + (size_t)MROWS * MW * 2, Y_END = Y_MKB + (size_t)4096 * MW * 2;
static_assert(Y_END <= (size_t)MP * DM * 4, "y scratch");
constexpr size_t W_XB = 0, W_WTA = W_XB + (size_t)(MROWS + MM) * DM * 2, W_QB = W_WTA + (size_t)16640 * DM * 2,
                 W_KB = W_QB + (size_t)(MROWS + 256) * FW * 2, W_VB = W_KB + (size_t)MP * FW * 2, W_U = W_VB + (size_t)MP * FW * 2,
                 W_SGF = W_U + (size_t)MROWS * FW * 2, W_BGS = W_SGF + (size_t)MROWS * FW * 2, W_VT = W_BGS + (size_t)MROWS * FW * 2,
                 W_END = W_VT + (size_t)16 * MW * 256 * 2;
constexpr size_t W_P = W_WTA, W_WTC = W_P + (size_t)MROWS * MW * 2, W_WTO = W_WTC + (size_t)DM * 4096 * 2, W_A1END = W_WTO + (size_t)DM * DM * 2;
static_assert(W_A1END <= W_QB, "alias 1");
constexpr size_t W_GS = W_QB, W_MSC = W_GS + (size_t)256 * 131072, W_MB = W_MSC + (size_t)256 * 262144, W_WTM = W_MB + (size_t)MROWS * DM * 2,
                 W_A2END = W_WTM + (size_t)6144 * DM * 2;
static_assert(W_A2END <= W_SGF, "alias 2");
static_assert(W_END <= (size_t)536870912, "workspace");

constexpr int LDS_STAGE = 131072, LDS_X = LDS_STAGE, LDS_BYTES = LDS_STAGE + 8192;

struct Params { const float* in[22]; float* out; unsigned char* ws; };
enum { I_XP = 0, I_XS, I_MEM, I_CFK, I_CFV, I_CFL, I_SCONV, I_CMK, I_CMV, I_WIN, I_FBF, I_CW, I_CB, I_WMKV, I_WFO, I_WCO, I_WMO, I_WMG, I_BMG, I_WO, I_LNG, I_LNB };

typedef __bf16 bf16x2_t __attribute__((ext_vector_type(2)));
typedef float f32x2_t __attribute__((ext_vector_type(2)));
__device__ __forceinline__ unsigned cvtpk(float lo, float hi) { const f32x2_t f = {lo, hi}; const bf16x2_t r = __builtin_convertvector(f, bf16x2_t); return __builtin_bit_cast(unsigned, r); }
__device__ __forceinline__ float bflo(unsigned w) { return __uint_as_float(w << 16); }
__device__ __forceinline__ float bfhi(unsigned w) { return __uint_as_float(w & 0xffff0000u); }
__device__ __forceinline__ float bf2f(bf16_t b) { return __uint_as_float(((unsigned)b) << 16); }
__device__ __forceinline__ u32x4 pack8u(f32x4 a, f32x4 b) { u32x4 w = {cvtpk(a[0], a[1]), cvtpk(a[2], a[3]), cvtpk(b[0], b[1]), cvtpk(b[2], b[3])}; return w; }
__device__ __forceinline__ bf16x8 pack8(f32x4 a, f32x4 b) { u32x4 w = pack8u(a, b); return *reinterpret_cast<bf16x8*>(&w); }
__device__ __forceinline__ float sigmoidf_(float x) { return __builtin_amdgcn_rcpf(1.f + __expf(-x)); }
__device__ __forceinline__ float siluf_(float x) { return x * sigmoidf_(x); }
__device__ __forceinline__ void unpack8(u32x4 w, float (&f)[8]) { f[0] = bflo(w.x); f[1] = bfhi(w.x); f[2] = bflo(w.y); f[3] = bfhi(w.y); f[4] = bflo(w.z); f[5] = bfhi(w.z); f[6] = bflo(w.w); f[7] = bfhi(w.w); }
__device__ __forceinline__ int otid() { int t = threadIdx.x; asm volatile("" : "+v"(t)); return t; }
__host__ __device__ __forceinline__ int perm32(int rho) { const int n = rho >> 4, i = rho & 15; return 8 * (i >> 2) + 4 * n + (i & 3); }
__host__ __device__ __forceinline__ int perm32inv(int l) { return 16 * ((l >> 2) & 1) + 4 * (l >> 3) + (l & 3); }

constexpr int BK = 64, HTB = 128 * BK * 2;
__device__ __forceinline__ int lds_byte(int r, int c) { const int st = (r >> 4) * 2 + (c >> 5), rr = r & 15, cc = c & 31, ob = rr * 64 + cc * 2; return st * 1024 + (ob ^ (((ob >> 9) & 1) << 5)); }
__device__ __forceinline__ void stage_rc(int b, int& R, int& C) { const int st = b / 1024, sb = b % 1024, swz = sb ^ (((sb >> 9) & 1) << 5); R = (st >> 1) * 16 + swz / 64; C = (st & 1) * 32 + (swz % 64) / 2; }

struct Unit { const char* A; const char* B; int lda, ldb, nt, kind, pm, pn, aux; };

template <class Sched, class Epi>
__device__ __forceinline__ void gemm_phase(LAS unsigned char* lds, const Sched& S, const Epi& E) {
    const int tid = otid(), wid = __builtin_amdgcn_readfirstlane(tid >> 6), lane = tid & 63, wr = wid >> 2, wc = wid & 3, fr = lane & 15, fq = lane >> 4;
    int sR0, sC0; stage_rc(tid * 16, sR0, sC0); const int sC2 = sC0 * 2;
    const size_t kstep = (size_t)(BK * 2);
    const unsigned ldsw = (unsigned)wid * 1024u;
    const int aoff = lds_byte(wr * 64 + fr, fq * 8), boff = lds_byte(wc * 32 + fr, fq * 8);
#define G_SA(b, h) (((b) * 2 + (h)) * HTB)
#define G_SB(b, h) ((4 + (b) * 2 + (h)) * HTB)
#define G_STAGE(bufoff, gbase, ld2) do { const unsigned v_ = (unsigned)sR0 * (unsigned)(ld2) + (unsigned)sC2; \
        __builtin_amdgcn_global_load_lds((const unsigned*)((const char*)(gbase) + v_), (LAS unsigned*)(lds + (bufoff) + ldsw), 16, 0, 0); \
        __builtin_amdgcn_global_load_lds((const unsigned*)((const char*)(gbase) + (size_t)(64u * (unsigned)(ld2)) + v_), (LAS unsigned*)(lds + (bufoff) + ldsw + 8192), 16, 0, 0); } while (0)
#define G_LDA(dst, b, h) do { _Pragma("unroll") for (int m = 0; m < 4; ++m) _Pragma("unroll") for (int k = 0; k < 2; ++k) dst[m][k] = *(const LAS bf16x8*)(lds + G_SA(b, h) + aoff + m * 2048 + k * 1024); } while (0)
#define G_LDB(dst, b, h) do { _Pragma("unroll") for (int n = 0; n < 2; ++n) _Pragma("unroll") for (int k = 0; k < 2; ++k) dst[n][k] = *(const LAS bf16x8*)(lds + G_SB(b, h) + boff + n * 2048 + k * 1024); } while (0)
#define G_MMA(ai, bj, At, Bt) do { __builtin_amdgcn_s_setprio(1); _Pragma("unroll") for (int m = 0; m < 4; ++m) _Pragma("unroll") for (int n = 0; n < 2; ++n) _Pragma("unroll") for (int k = 0; k < 2; ++k) \
        acc[ai][bj][m][n] = __builtin_amdgcn_mfma_f32_16x16x32_bf16(Bt[n][k], At[m][k], acc[ai][bj][m][n], 0, 0, 0); __builtin_amdgcn_s_setprio(0); } while (0)
#define G_WAIT_V(n) asm volatile("s_waitcnt vmcnt(" #n ")" ::: "memory")
#define G_WAIT_L(n) asm volatile("s_waitcnt lgkmcnt(" #n ")" ::: "memory")
#define G_BAR __builtin_amdgcn_s_barrier()
#define G_SCHED __builtin_amdgcn_sched_barrier(0)
    Unit cur, nxt; int ui = 0;
    if (!S.next(0, cur)) return;
    f32x4 acc[2][2][4][2];
#pragma unroll
    for (int a = 0; a < 2; ++a)
#pragma unroll
        for (int b = 0; b < 2; ++b)
#pragma unroll
            for (int m = 0; m < 4; ++m)
#pragma unroll
                for (int n = 0; n < 2; ++n) acc[a][b][m][n] = (f32x4){0.f, 0.f, 0.f, 0.f};
    bf16x8 At[4][2], B0[2][2], B1[2][2];
    const char* cA = cur.A; const char* cB = cur.B;
    int lA2 = cur.lda * 2, lB2 = cur.ldb * 2;
    size_t hA = (size_t)128 * lA2, hB = (size_t)128 * lB2;
    G_STAGE(G_SB(0, 0), cB, lB2); G_STAGE(G_SA(0, 0), cA, lA2); G_STAGE(G_SB(0, 1), cB + hB, lB2); G_STAGE(G_SA(0, 1), cA + hA, lA2);
    if (wr == 1) G_BAR;
    G_WAIT_V(4); G_BAR;
    G_STAGE(G_SB(1, 0), cB + kstep, lB2); G_STAGE(G_SA(1, 0), cA + kstep, lA2); G_STAGE(G_SB(1, 1), cB + hB + kstep, lB2);
    G_WAIT_V(6); G_BAR;
    for (;;) {
        const bool has_next = S.next(ui + 1, nxt);
        if (!has_next) nxt = cur;
        const char* nA = nxt.A; const char* nB = nxt.B;
        const int nlA2 = nxt.lda * 2, nlB2 = nxt.ldb * 2;
        const size_t nhA = (size_t)128 * nlA2, nhB = (size_t)128 * nlB2;
        const int nt = cur.nt;
        for (int t = 0; t < nt; t += 2) {
            const bool last = (t == nt - 2);
            const char* a1 = cA + (size_t)(t + 1) * kstep;
            const char* a2 = last ? nA : cA + (size_t)(t + 2) * kstep; const char* b2 = last ? nB : cB + (size_t)(t + 2) * kstep;
            const char* a3 = a2 + kstep; const char* b3 = b2 + kstep;
            const int xlA2 = last ? nlA2 : lA2, xlB2 = last ? nlB2 : lB2;
            const size_t xhA = last ? nhA : hA, xhB = last ? nhB : hB;
            G_LDB(B0, 0, 0); G_SCHED; G_LDA(At, 0, 0); G_STAGE(G_SA(1, 1), a1 + hA, lA2);
            G_WAIT_L(8); G_BAR; G_WAIT_L(0); G_MMA(0, 0, At, B0); G_BAR; G_SCHED;
            G_LDB(B1, 0, 1); G_STAGE(G_SB(0, 0), b2, xlB2);
            G_BAR; G_WAIT_L(0); G_MMA(0, 1, At, B1); G_BAR;
            G_LDA(At, 0, 1); G_STAGE(G_SA(0, 0), a2, xlA2);
            G_BAR; G_WAIT_L(0); G_MMA(1, 0, At, B0); G_BAR; G_SCHED;
            G_STAGE(G_SB(0, 1), b2 + xhB, xlB2);
            G_WAIT_V(6); G_BAR; G_MMA(1, 1, At, B1); G_BAR;
            G_LDB(B0, 1, 0); G_SCHED; G_LDA(At, 1, 0); G_STAGE(G_SA(0, 1), a2 + xhA, xlA2);
            G_WAIT_L(8); G_BAR; G_WAIT_L(0); G_MMA(0, 0, At, B0); G_BAR; G_SCHED;
            G_LDB(B1, 1, 1); G_STAGE(G_SB(1, 0), b3, xlB2);
            G_BAR; G_WAIT_L(0); G_MMA(0, 1, At, B1); G_BAR;
            G_LDA(At, 1, 1); G_STAGE(G_SA(1, 0), a3, xlA2);
            G_BAR; G_WAIT_L(0); G_MMA(1, 0, At, B0); G_BAR; G_SCHED;
            G_STAGE(G_SB(1, 1), b3 + xhB, xlB2);
            G_WAIT_V(6); G_BAR; G_MMA(1, 1, At, B1); G_BAR;
        }
        E(acc, cur, wr, wc, fr, fq, lds);
        if (!has_next) break;
#pragma unroll
        for (int a = 0; a < 2; ++a)
#pragma unroll
            for (int b = 0; b < 2; ++b)
#pragma unroll
                for (int m = 0; m < 4; ++m)
#pragma unroll
                    for (int n = 0; n < 2; ++n) acc[a][b][m][n] = (f32x4){0.f, 0.f, 0.f, 0.f};
        cur = nxt; cA = nA; cB = nB; lA2 = nlA2; lB2 = nlB2; hA = nhA; hB = nhB; ++ui;
    }
    G_WAIT_V(0);
    if (wr == 0) G_BAR;
    G_BAR;
#undef G_STAGE
#undef G_LDA
#undef G_LDB
#undef G_MMA
}

__device__ __forceinline__ void conv_rows(const float* src, bf16_t* dst, size_t n8, size_t g0, size_t gs) {
    for (size_t i = g0; i < n8; i += gs) { const f32x4 a = *(const f32x4*)(src + i * 8), b = *(const f32x4*)(src + i * 8 + 4); *(u32x4*)(dst + i * 8) = pack8u(a, b); }
}
__device__ __forceinline__ int colmapA(int lc) {
    const int t = lc >> 8, o = lc & 255;
    if (t < 18) return lc;
    if (t < 24) return 4620 + (lc - 4608);
    if (t < 36) { const int i = t - 24; return (o < 128) ? 7692 + 128 * i + o : 9228 + 128 * i + (o - 128); }
    if (t < 48) { const int i = t - 36; return (o < 128) ? 6156 + 128 * i + o : 10764 + 128 * i + (o - 128); }
    if (t < 52) return 12300 + (lc - 48 * 256);
    if (t < 56) return 13324 + (lc - 52 * 256);
    return (o < 12) ? 4608 + o : -1;
}
template <int MODE>
__device__ __forceinline__ void tr_tile(const float* src, int sld, bf16_t* dst, int dld, int j0, int k0, float* tile) {
    const int tid = otid();
    { const int jj = tid & 63, kk0 = tid >> 6; const int j = j0 + jj; int col;
      if (MODE == 2) col = j; else { const int lc = (j & ~31) + perm32(j & 31); col = (MODE == 1) ? colmapA(lc) : lc; }
#pragma unroll
      for (int i = 0; i < 8; ++i) { const int kk = kk0 + 8 * i; tile[kk * 65 + jj] = (col >= 0) ? src[(size_t)(k0 + kk) * sld + col] : 0.f; } }
    __syncthreads();
    { const int jj = tid >> 3, ks = tid & 7; float v[8];
#pragma unroll
      for (int e = 0; e < 8; ++e) v[e] = tile[(ks * 8 + e) * 65 + jj];
      u32x4 w = {cvtpk(v[0], v[1]), cvtpk(v[2], v[3]), cvtpk(v[4], v[5]), cvtpk(v[6], v[7])};
      *(u32x4*)(dst + (size_t)(j0 + jj) * dld + k0 + ks * 8) = w; }
    __syncthreads();
}
template <int MODE>
__device__ __forceinline__ void tr_matrix(const float* src, int sld, bf16_t* dst, int dld, int nj, int nk, float* tile, int& ctr, int G, int c) {
    const int tj = nj / 64, tk = nk / 64, total = tj * tk;
    for (int t = 0; t < total; ++t, ++ctr) { if ((ctr % G) != c) continue; tr_tile<MODE>(src, sld, dst, dld, (t / tk) * 64, (t % tk) * 64, tile); }
}

__device__ __forceinline__ void phase_prep(const Params& p, char* smem) {
    float* tile = (float*)smem;
    unsigned char* ws = p.ws; unsigned char* ys = (unsigned char*)p.out;
    const int G = gridDim.x, c = blockIdx.x; const size_t g0 = (size_t)c * 512 + otid(), gs = (size_t)G * 512;
    bf16_t* XB = (bf16_t*)(ws + W_XB);
    int ctr = 0;
    tr_matrix<1>(p.in[I_WIN], INW, (bf16_t*)(ws + W_WTA), DM, NTA * 256, DM, tile, ctr, G, c);
    tr_matrix<0>(p.in[I_WMKV], 2048, (bf16_t*)(ws + W_WTA) + (size_t)NTA * 256 * DM, DM, 2048, DM, tile, ctr, G, c);
    for (int b = 0; b < NBATCH; ++b)
        tr_matrix<0>(p.in[I_CMV] + (size_t)b * 256 * MW, MW, (bf16_t*)(ws + W_VT) + (size_t)(8 + b) * MW * 256, 256, MW, 256, tile, ctr, G, c);
    conv_rows(p.in[I_XP], XB, (size_t)MP * DM / 8, g0, gs);
    conv_rows(p.in[I_XS], XB + (size_t)MP * DM, (size_t)MS * DM / 8, g0, gs);
    conv_rows(p.in[I_MEM], XB + (size_t)MROWS * DM, (size_t)MM * DM / 8, g0, gs);
    conv_rows(p.in[I_CMK], (bf16_t*)(ys + Y_MKB) + (size_t)2048 * MW, (size_t)2048 * MW / 8, g0, gs);
    {
        bf16_t* KS = (bf16_t*)(ys + Y_KS); bf16_t* VS = (bf16_t*)(ys + Y_VS); const float* ck = p.in[I_CFK]; const float* cv = p.in[I_CFV];
        const size_t n8 = (size_t)NBATCH * PAST * FW / 8;
        for (size_t i = g0; i < n8; i += gs) { const size_t e = i * 8, row = e / FW, col = e % FW, b = row / PAST, pp = row % PAST; const size_t d = ((b * SKVS + pp) * FW + col);
            *(u32x4*)(KS + d) = pack8u(*(const f32x4*)(ck + e), *(const f32x4*)(ck + e + 4)); *(u32x4*)(VS + d) = pack8u(*(const f32x4*)(cv + e), *(const f32x4*)(cv + e + 4)); }
    }
}

enum { KQ = 0, KK, KV, KGF, KCH, KBG, KMQ, KGM, KF, KMK, KMV };
struct SchedB {
    int G, c; const char* XB; const char* WTA;
    __device__ __forceinline__ bool next(int i, Unit& u) const {
        const int NU1 = NPAN * NTA, NU2 = 64; const long L = (long)i * G + c; if (L >= NU1 + NU2) return false;
        int pm, pn;
        if (L < NU1) { int wgid = (int)L; const int nwg = NU1; { const int q = nwg / 8, r = nwg % 8, xcd = wgid % 8, off = wgid / 8; wgid = (xcd < r ? xcd * (q + 1) : r * (q + 1) + (xcd - r) * q) + off; }
            const int nig = 8 * NTA, gid = wgid / nig, fm = gid * 8, gsz = (NPAN - fm) < 8 ? (NPAN - fm) : 8; pm = fm + ((wgid % nig) % gsz); pn = (wgid % nig) / gsz; }
        else { const int l2 = (int)L - NU1; pm = NPAN + (l2 & 7); pn = NTA + (l2 >> 3); }
        u.pm = pm; u.pn = pn; u.lda = DM; u.ldb = DM; u.nt = DM / BK;
        u.A = XB + (size_t)pm * 256 * DM * 2; u.B = WTA + (size_t)pn * 256 * DM * 2;
        int kind, aux;
        if (pn < 6) { kind = KQ; aux = pn; } else if (pn < 12) { kind = KK; aux = pn - 6; } else if (pn < 18) { kind = KV; aux = pn - 12; } else if (pn < 24) { kind = KGF; aux = pn - 18; }
        else if (pn < 36) { kind = KCH; aux = pn - 24; } else if (pn < 48) { kind = KBG; aux = pn - 36; } else if (pn < 52) { kind = KMQ; aux = pn - 48; } else if (pn < 56) { kind = KGM; aux = pn - 52; }
        else if (pn < 57) { kind = KF; aux = 0; } else if (pn < 61) { kind = KMK; aux = pn - 57; } else { kind = KMV; aux = pn - 61; }
        u.kind = kind; u.aux = aux; return true;
    }
};
struct EpiB {
    float* out; unsigned char* ws; const float* fbf;
    __device__ __forceinline__ void operator()(const f32x4 (&acc)[2][2][4][2], const Unit& u, int wr, int wc, int fr, int fq, LAS unsigned char*) const {
        unsigned char* ys = (unsigned char*)out;
        const int kind = u.kind, aux = u.aux, rbase = u.pm * 256 + wr * 64 + fr, cl = wc * 32 + fq * 8;
        const bool prompt = u.pm < 64;
        if (kind == KQ || kind == KGF || kind == KMQ || kind == KGM) {
            bf16_t* dst; int ld;
            if (kind == KQ) { dst = (bf16_t*)(ws + W_QB); ld = FW; } else if (kind == KGF) { dst = (bf16_t*)(ws + W_SGF); ld = FW; } else if (kind == KMQ) { dst = (bf16_t*)(ys + Y_MQ); ld = MW; } else { dst = (bf16_t*)(ys + Y_SGM); ld = MW; }
            const bool act = (kind == KGF || kind == KGM);
#pragma unroll
            for (int ai = 0; ai < 2; ++ai)
#pragma unroll
                for (int m = 0; m < 4; ++m) { bf16_t* rp = dst + (size_t)(rbase + ai * 128 + m * 16) * ld + aux * 256 + cl;
#pragma unroll
                    for (int bj = 0; bj < 2; ++bj) { f32x4 a = acc[ai][bj][m][0], b = acc[ai][bj][m][1];
                        if (act) {
#pragma unroll
                            for (int j = 0; j < 4; ++j) { a[j] = siluf_(a[j]); b[j] = siluf_(b[j]); } }
                        *(u32x4*)(rp + bj * 128) = pack8u(a, b); } }
        } else if (kind == KK || kind == KV) {
#pragma unroll
            for (int ai = 0; ai < 2; ++ai)
#pragma unroll
                for (int m = 0; m < 4; ++m) { const int row = rbase + ai * 128 + m * 16; float* fo; bf16_t* bo;
                    if (prompt) { fo = out + (kind == KK ? O_FKP : O_FVP) + (size_t)row * FW; bo = (bf16_t*)(ws + (kind == KK ? W_KB : W_VB)) + (size_t)row * FW; }
                    else { const int rs = row - MP; fo = out + (kind == KK ? O_FKS : O_FVS) + (size_t)rs * FW; bo = (bf16_t*)(ys + (kind == KK ? Y_KS : Y_VS)) + ((size_t)(rs >> 6) * SKVS + PAST + (rs & 63)) * FW; }
#pragma unroll
                    for (int bj = 0; bj < 2; ++bj) { const int col = aux * 256 + bj * 128 + cl; const f32x4 a = acc[ai][bj][m][0], b = acc[ai][bj][m][1];
                        *(f32x4*)(fo + col) = a; *(f32x4*)(fo + col + 4) = b; *(u32x4*)(bo + col) = pack8u(a, b); } }
        } else if (kind == KCH) {
            bf16_t* U = (bf16_t*)(ws + W_U);
#pragma unroll
            for (int ai = 0; ai < 2; ++ai)
#pragma unroll
                for (int m = 0; m < 4; ++m) { const int row = rbase + ai * 128 + m * 16; const int ch = aux * 128 + cl;
                    const f32x4 a = acc[ai][0][m][0] * acc[ai][1][m][0], b = acc[ai][0][m][1] * acc[ai][1][m][1];
                    *(u32x4*)(U + (size_t)row * FW + ch) = pack8u(a, b);
                    float* tp = nullptr;
                    if (prompt) { const int s = row & (SEQ - 1); if (s >= SEQ - 2) tp = out + O_CVP + ((size_t)(row >> 11) * 2 + (s - (SEQ - 2))) * FW + ch; }
                    else { const int rs = row - MP, t = rs & 63; if (t >= DECS - 2) tp = out + O_CVS + ((size_t)(rs >> 6) * 2 + (t - (DECS - 2))) * FW + ch; }
                    if (tp) { *(f32x4*)tp = a; *(f32x4*)(tp + 4) = b; } }
        } else if (kind == KBG) {
            bf16_t* BG = (bf16_t*)(ws + W_BGS);
#pragma unroll
            for (int ai = 0; ai < 2; ++ai)
#pragma unroll
                for (int m = 0; m < 4; ++m) { const int row = rbase + ai * 128 + m * 16; const int ch = aux * 128 + cl; f32x4 a, b;
#pragma unroll
                    for (int j = 0; j < 4; ++j) { a[j] = acc[ai][0][m][0][j] * siluf_(acc[ai][1][m][0][j]); b[j] = acc[ai][0][m][1][j] * siluf_(acc[ai][1][m][1][j]); }
                    *(u32x4*)(BG + (size_t)row * FW + ch) = pack8u(a, b); }
        } else if (kind == KF) {
            if (wc == 0 && fq < 2) {
#pragma unroll
                for (int ai = 0; ai < 2; ++ai)
#pragma unroll
                    for (int m = 0; m < 4; ++m) { const int row = rbase + ai * 128 + m * 16; float* lp = prompt ? out + O_FLP + (size_t)row * NH : out + O_FLS + (size_t)(row - MP) * NH;
#pragma unroll
                        for (int n = 0; n < 2; ++n)
#pragma unroll
                            for (int j = 0; j < 4; ++j) { const int col = fq * 8 + n * 4 + j; if (col < NH) { const float x = acc[ai][0][m][n][j] + fbf[col];
                                lp[col] = (x < 0.f) ? x - log1pf(expf(x)) : -log1pf(expf(-x)); } } }
            }
        } else {
#pragma unroll
            for (int ai = 0; ai < 2; ++ai)
#pragma unroll
                for (int m = 0; m < 4; ++m) { const int rm = rbase + ai * 128 + m * 16 - MROWS; float* fo = out + (kind == KMK ? O_MKP : O_MVP) + (size_t)rm * MW;
#pragma unroll
                    for (int bj = 0; bj < 2; ++bj) { const int col = aux * 256 + bj * 128 + cl; const f32x4 a = acc[ai][bj][m][0], b = acc[ai][bj][m][1];
                        *(f32x4*)(fo + col) = a; *(f32x4*)(fo + col + 4) = b;
                        if (kind == KMK) { *(u32x4*)((bf16_t*)(ys + Y_MKB) + (size_t)rm * MW + col) = pack8u(a, b); }
                        else { bf16_t* vt = (bf16_t*)(ws + W_VT) + (size_t)(rm >> 8) * MW * 256 + (rm & 255); const u32x4 w = pack8u(a, b); const unsigned ww[4] = {w.x, w.y, w.z, w.w};
#pragma unroll
                            for (int e = 0; e < 8; ++e) { const int lc = col + e; const int rp = (lc & ~31) + perm32inv(lc & 31); vt[(size_t)rp * 256] = (bf16_t)((e & 1) ? (ww[e >> 1] >> 16) : (ww[e >> 1] & 0xffffu)); } } } }
        }
    }
};

namespace att {
constexpr int D = 128, LDQ = FW, NW = 8, QBLK = 32, KVBLK = 64, QB = NW * QBLK;
constexpr int SHM_V = KVBLK * D * 2, SHM_K = KVBLK * D * 2;
constexpr int OFF_LI = 2 * SHM_V + 2 * SHM_K, OFF_KX = OFF_LI + NW * 64 * 4, OFF_CS = OFF_KX + 2048 * 4, OFF_END = OFF_CS + 256;
static_assert(OFF_END <= LDS_STAGE, "attention LDS");
constexpr float SCALE = 0.08838834764831845f, THR = 8.f;
#define KSWZ(row, colB) ((row) * 256 + ((colB) ^ (((row) & 7) << 4)))
#define SBAR() __builtin_amdgcn_sched_barrier(0)
__device__ __forceinline__ int v_st(int k, int c) { const int kk = (k & ~0xC) | ((k & 4) << 1) | ((k & 8) >> 1); return ((kk >> 3) * 4 + (c >> 5)) * 512 + ((kk & 7) * 32 + (c & 31)) * 2; }
__device__ __forceinline__ int v_rd_base(int lane) { return ((lane & 3) << 3) | (((lane >> 2) & 3) << 6) | (((lane >> 4) & 1) << 5) | (((lane >> 5) & 1) << 8); }
constexpr int v_rd_off(int d0, int ks, int half) { return d0 * 512 + ks * 4096 + half * 2048; }
__device__ __forceinline__ int crow(int r, int hi) { return (r & 3) + 8 * (r >> 2) + 4 * hi; }
__device__ __forceinline__ bf16x8 load8(const bf16_t* p) { return *reinterpret_cast<const bf16x8*>(p); }
__device__ __forceinline__ void mask_tile(f32x16& p0, f32x16& p1, int dq, unsigned W) {
    const float NEG = -__builtin_inff();
#pragma unroll
    for (int r = 0; r < 16; ++r) { const int c = (r & 3) + 8 * (r >> 2); if ((unsigned)(dq - c) >= W) p0[r] = NEG; if ((unsigned)(dq - c - 32) >= W) p1[r] = NEG; }
}
__device__ __forceinline__ void partialSM(f32x16& p0, f32x16& p1, float& m_reg, float& mn, float& alpha) {
    float pmax = p0[0]; for (int r = 1; r < 16; ++r) pmax = fmaxf(pmax, p0[r]); for (int r = 0; r < 16; ++r) pmax = fmaxf(pmax, p1[r]);
    { auto rr = __builtin_amdgcn_permlane32_swap(__float_as_uint(pmax), __float_as_uint(pmax), false, false); pmax = fmaxf(__uint_as_float(rr[0]), __uint_as_float(rr[1])); }
    constexpr float C2 = 1.4426950408889634f * SCALE;
    if (__builtin_expect(__all((pmax - m_reg) * SCALE <= THR), 1)) { mn = m_reg; alpha = 1.f; }
    else { mn = fmaxf(m_reg, pmax); alpha = __builtin_amdgcn_exp2f((m_reg - mn) * C2); m_reg = mn; }
    const float mnL = -mn * C2;
    for (int r = 0; r < 16; ++r) p0[r] = fmaf(p0[r], C2, mnL); for (int r = 0; r < 16; ++r) p1[r] = fmaf(p1[r], C2, mnL);
    for (int r = 0; r < 16; ++r) p0[r] = __builtin_amdgcn_exp2f(p0[r]);
}
__device__ __forceinline__ void finishSM(f32x16& p0, f32x16& p1, float alpha, float& l_reg, bf16x8& pa0, bf16x8& pa1, bf16x8& pa2, bf16x8& pa3) {
    for (int r = 0; r < 16; ++r) p1[r] = __builtin_amdgcn_exp2f(p1[r]);
    float ps = 0; for (int r = 0; r < 16; ++r) ps += p0[r]; for (int r = 0; r < 16; ++r) ps += p1[r];
    { auto rr = __builtin_amdgcn_permlane32_swap(__float_as_uint(ps), __float_as_uint(ps), false, false); ps = __uint_as_float(rr[0]) + __uint_as_float(rr[1]); }
    l_reg = l_reg * alpha + ps;
#define PK4(P, B_, OUT) do { unsigned a0 = cvtpk(P[B_+0], P[B_+1]), a1 = cvtpk(P[B_+2], P[B_+3]);                          \
        unsigned b0 = cvtpk(P[B_+4], P[B_+5]), b1 = cvtpk(P[B_+6], P[B_+7]);                                             \
        auto r0 = __builtin_amdgcn_permlane32_swap(a0, b0, false, false); auto r1 = __builtin_amdgcn_permlane32_swap(a1, b1, false, false); \
        u32x4 w = {r0[0], r1[0], r0[1], r1[1]}; OUT = *reinterpret_cast<bf16x8*>(&w); } while (0)
    PK4(p0, 0, pa0); PK4(p0, 8, pa1); PK4(p1, 0, pa2); PK4(p1, 8, pa3);
#undef PK4
}
template <int KB>
__device__ __forceinline__ void qkt(f32x16& p0, f32x16& p1, const char* K_lds, int r32, int hi, const bf16x8* qr, const float* bt) {
#pragma unroll
    for (int g = 0; g < 4; ++g) { const f32x4 a = *(const f32x4*)(bt + 8 * g), b = *(const f32x4*)(bt + 32 + 8 * g);
        p0[4 * g] = a[0]; p0[4 * g + 1] = a[1]; p0[4 * g + 2] = a[2]; p0[4 * g + 3] = a[3]; p1[4 * g] = b[0]; p1[4 * g + 1] = b[1]; p1[4 * g + 2] = b[2]; p1[4 * g + 3] = b[3]; }
    const char* kb[4];
#pragma unroll
    for (int dd = 0; dd < 4; ++dd) kb[dd] = K_lds + KB * SHM_K + KSWZ(r32, (dd * 16 + hi * 8) * 2);
#pragma unroll
    for (int d0 = 0; d0 < 8; ++d0) { const char* a = kb[d0 & 3] + (d0 >> 2) * 128;
        bf16x8 b0 = *reinterpret_cast<const bf16x8*>(a);
        bf16x8 b1 = *reinterpret_cast<const bf16x8*>(a + 32 * 256);
        p0 = __builtin_amdgcn_mfma_f32_32x32x16_bf16(b0, qr[d0], p0, 0, 0, 0);
        p1 = __builtin_amdgcn_mfma_f32_32x32x16_bf16(b1, qr[d0], p1, 0, 0, 0); }
}
template <int VB>
__device__ __forceinline__ void pv_tile(f32x16* o, int vb0, bf16x8 pa0, bf16x8 pa1, bf16x8 pa2, bf16x8 pa3) {
#define TRRD(dst, off) asm volatile("ds_read_b64_tr_b16 %0, %1 offset:%2" : "=&v"(dst) : "v"(vb0), "i"(off) : "memory")
#define PV_D0(d0) do { s16x4 l0, l1, l2, l3, h0, h1, h2, h3; constexpr int b_ = VB * SHM_V + v_rd_off(d0, 0, 0); \
        TRRD(l0, b_); TRRD(h0, b_ + 2048); TRRD(l1, b_ + 4096); TRRD(h1, b_ + 6144); TRRD(l2, b_ + 8192); TRRD(h2, b_ + 10240); TRRD(l3, b_ + 12288); TRRD(h3, b_ + 14336); \
        asm volatile("s_waitcnt lgkmcnt(0)" ::: "memory"); SBAR(); \
        o[d0] = __builtin_amdgcn_mfma_f32_32x32x16_bf16(pa0, (bf16x8){l0[0], l0[1], l0[2], l0[3], h0[0], h0[1], h0[2], h0[3]}, o[d0], 0, 0, 0);   \
        o[d0] = __builtin_amdgcn_mfma_f32_32x32x16_bf16(pa1, (bf16x8){l1[0], l1[1], l1[2], l1[3], h1[0], h1[1], h1[2], h1[3]}, o[d0], 0, 0, 0);   \
        o[d0] = __builtin_amdgcn_mfma_f32_32x32x16_bf16(pa2, (bf16x8){l2[0], l2[1], l2[2], l2[3], h2[0], h2[1], h2[2], h2[3]}, o[d0], 0, 0, 0);   \
        o[d0] = __builtin_amdgcn_mfma_f32_32x32x16_bf16(pa3, (bf16x8){l3[0], l3[1], l3[2], l3[3], h3[0], h3[1], h3[2], h3[3]}, o[d0], 0, 0, 0); } while (0)
    PV_D0(0); PV_D0(1); PV_D0(2); PV_D0(3);
#undef PV_D0
#undef TRRD
}
struct BlockRef { const bf16_t* Q; const bf16_t* K; const bf16_t* V; bf16_t* O; int P0, skv, nvalid; };
struct Seam { bf16x8 qr[8]; bf16x8 st_v0, st_v1, st_k0, st_k1; };
#define ROW(p, k0, rr) ((p) + (size_t)((k0) + (rr)) * LDQ + sc)
#define VMW() asm volatile("s_waitcnt vmcnt(0)" ::: "memory")
#define VMWN(n) asm volatile("s_waitcnt vmcnt(%0)" :: "i"(n) : "memory")
#define SLOAD_H(Kp, Vp, k0) do { S.st_v0 = load8(ROW(Vp, k0, sr)); S.st_v1 = load8(ROW(Vp, k0, 32 + sr)); S.st_k0 = load8(ROW(Kp, k0, sr)); S.st_k1 = load8(ROW(Kp, k0, 32 + sr)); } while (0)
#define SWRITE_HK(bf) do { *(bf16x8*)(K_lds + (bf) * SHM_K + kws) = S.st_k0; *(bf16x8*)(K_lds + (bf) * SHM_K + kws + 32 * 256) = S.st_k1; } while (0)
#define SWRITE_HV(bf) do { *(bf16x8*)(V_lds + (bf) * SHM_V + vst0) = S.st_v0; *(bf16x8*)(V_lds + (bf) * SHM_V + vst1) = S.st_v1; } while (0)
#define SWRITE_H(bf) do { SWRITE_HV(bf); SWRITE_HK(bf); } while (0)
__device__ __forceinline__ void prime(const BlockRef& cur, char* lds, Seam& S) {
    const int tid = otid(), wid = __builtin_amdgcn_readfirstlane(tid >> 6), lane = tid & 63, r32 = lane & 31, hi = lane >> 5;
    const int sr = tid >> 4, sc = (tid & 15) * 8, kws = KSWZ(sr, sc * 2); char* K_lds = lds + 2 * SHM_V;
    for (int d0 = 0; d0 < 8; ++d0) S.qr[d0] = load8(cur.Q + (size_t)(wid * QBLK + r32) * LDQ + d0 * 16 + hi * 8);
    SLOAD_H(cur.K, cur.V, 0); VMW(); SWRITE_HK(0);
    __syncthreads();
}
__device__ __forceinline__ void block(const BlockRef& cur, const BlockRef& nxt, char* lds, Seam& S) {
    const int tid = otid(), wid = __builtin_amdgcn_readfirstlane(tid >> 6), lane = tid & 63, r32 = lane & 31, hi = lane >> 5;
    constexpr int W = 1 << 24;
    int j_hi = (cur.P0 + QB - 1) / KVBLK + 1; if (j_hi > cur.skv / KVBLK) j_hi = cur.skv / KVBLK;
    const int NT = j_hi;
    const int qlo = cur.P0 + wid * QBLK, qm = qlo + r32 - 4 * hi;
    char* V_lds = lds; char* K_lds = lds + 2 * SHM_V; const float* KXf = (const float*)(lds + OFF_KX) + 4 * hi;
    float* wsl = (float*)(lds + OFF_LI) + wid * 64; float* li_l = wsl, * al_l = wsl + 32;
    float m_reg = -1e30f, l_reg = 0; f32x16 o[4] = {};
    const int sr = tid >> 4, sc = (tid & 15) * 8, vst0 = v_st(sr, sc), vst1 = v_st(32 + sr, sc), kws = KSWZ(sr, sc * 2);
    const int vb0 = (int)(uintptr_t)V_lds + v_rd_base(lane);
    const bf16_t* Kh = cur.K; const bf16_t* Vh = cur.V;
#define RESC(a) do { if (__any((a) < 1.f)) { if (hi == 0) al_l[r32] = (a); asm volatile("s_waitcnt lgkmcnt(0)" ::: "memory");              \
                     for (int d_ = 0; d_ < 4; ++d_) for (int r = 0; r < 16; ++r) o[d_][r] *= al_l[crow(r, hi)]; } } while (0)
#define KBASE(t) ((t) * KVBLK)
#define MASKT(P0_, P1_, t) do { const int kb_ = KBASE(t); if (kb_ + KVBLK - 1 > qlo) mask_tile(P0_, P1_, qm - kb_, (unsigned)W); } while (0)
#define SEAM_K0() do { VMWN(8); SWRITE_HK(0); SBAR(); } while (0)
    f32x16 pA0, pA1, pB0, pB1; float mnA, mnB, alA, alB; bf16x8 pa0, pa1, pa2, pa3;
    SWRITE_HV(0); SBAR();
    if (NT > 1) { SLOAD_H(Kh, Vh, KBASE(1)); }
    SBAR(); qkt<0>(pA0, pA1, K_lds, r32, hi, S.qr, KXf + KBASE(0));
    MASKT(pA0, pA1, 0); partialSM(pA0, pA1, m_reg, mnA, alA);
    if (NT > 1) { VMW(); SWRITE_H(1); }
    __syncthreads();
#define HALF_STEP(PX0, PX1, mnX, alX, PY0, PY1, alY, t, KB, VB, SB) do {                                                      \
        SBAR(); qkt<KB>(PX0, PX1, K_lds, r32, hi, S.qr, KXf + KBASE(t));                                              \
        finishSM(PY0, PY1, alY, l_reg, pa0, pa1, pa2, pa3); SBAR();                                                           \
        if ((t) + 1 < NT) { SLOAD_H(Kh, Vh, KBASE((t) + 1)); SBAR(); }                                                        \
        pv_tile<VB>(o, vb0, pa0, pa1, pa2, pa3); MASKT(PX0, PX1, (t)); partialSM(PX0, PX1, m_reg, mnX, alX);                  \
        __syncthreads();                                                                                                      \
        if ((t) + 1 < NT) { VMW(); SWRITE_H(SB); }                                                                            \
        RESC(alX); __syncthreads(); } while (0)
    for (int t = 1; t + 1 < NT; t += 2) {
        HALF_STEP(pB0, pB1, mnB, alB, pA0, pA1, alA, t, 1, 0, 0);
        HALF_STEP(pA0, pA1, mnA, alA, pB0, pB1, alB, t + 1, 0, 1, 1);
    }
    const bool even = (NT & 1) == 0;
    if (even) { SBAR(); qkt<1>(pB0, pB1, K_lds, r32, hi, S.qr, KXf + KBASE(NT - 1)); SBAR(); }
    SLOAD_H(nxt.K, nxt.V, 0); SBAR();
#pragma unroll
    for (int d0 = 0; d0 < 8; ++d0) S.qr[d0] = load8(nxt.Q + (size_t)(wid * QBLK + r32) * LDQ + d0 * 16 + hi * 8);
    SBAR();
    finishSM(pA0, pA1, alA, l_reg, pa0, pa1, pa2, pa3); SBAR();
    pv_tile<0>(o, vb0, pa0, pa1, pa2, pa3);
    if (even) { MASKT(pB0, pB1, NT - 1); partialSM(pB0, pB1, m_reg, mnB, alB); __syncthreads(); RESC(alB);
        finishSM(pB0, pB1, alB, l_reg, pa0, pa1, pa2, pa3); SBAR(); pv_tile<1>(o, vb0, pa0, pa1, pa2, pa3); }
    SBAR(); SEAM_K0();
    if (hi == 0) li_l[r32] = l_reg; asm volatile("s_waitcnt lgkmcnt(0)" ::: "memory");
    int r32e = r32, hie = hi; asm volatile("" : "+v"(r32e), "+v"(hie));
    const int lane_off = 4 * hie * LDQ + r32e;
    bf16_t* Ow = cur.O + (size_t)(wid * QBLK) * LDQ;
    const int nv = cur.nvalid - wid * QBLK;
#pragma unroll
    for (int r = 0; r < 16; ++r) { const int orow = crow(r, hi); const float rli = __builtin_amdgcn_rcpf(li_l[orow]);
        if (orow < nv) {
#pragma unroll
            for (int d0 = 0; d0 < 4; ++d0) { bf16_t* gp = Ow + (lane_off + ((r & 3) + 8 * (r >> 2)) * LDQ + d0 * 32); const float v = o[d0][r] * rli * bf2f(*gp);
                const float vn = __shfl_xor(v, 1);
                if ((r32e & 1) == 0) *(unsigned*)gp = cvtpk(v, vn); } } }
    __syncthreads();
#undef RESC
#undef KBASE
#undef MASKT
#undef SEAM_K0
#undef HALF_STEP
}
#undef ROW
#undef VMW
#undef VMWN
#undef SLOAD_H
#undef SWRITE_HK
#undef SWRITE_HV
#undef SWRITE_H

__device__ __forceinline__ void build_kx(const Params& p, char* lds, int b, int h, bool sample, int P0, int nkeys) {
    int tid = threadIdx.x; asm volatile("" : "+v"(tid));
    const int wid = tid >> 6, lane = tid & 63;
    float* cs = (float*)(lds + OFF_CS);
    float v[4];
#pragma unroll
    for (int e = 0; e < 4; ++e) { const int key = tid * 4 + e; float x = 0.f;
        if (key < nkeys) { if (!sample) x = p.out[O_FLP + ((size_t)b * SEQ + key) * NH + h]; else x = (key < PAST) ? p.in[I_CFL][((size_t)b * PAST + key) * NH + h] : p.out[O_FLS + ((size_t)b * DECS + (key - PAST)) * NH + h]; }
        v[e] = x; }
    v[1] += v[0]; v[2] += v[1]; v[3] += v[2];
    float tot = v[3], inc = tot;
#pragma unroll
    for (int s = 1; s < 64; s <<= 1) { const float t = __shfl_up(inc, s); if (lane >= s) inc += t; }
    if (lane == 63) cs[wid] = inc;
    __syncthreads();
    float off = inc - tot;
    for (int w = 0; w < wid; ++w) off += cs[w];
#pragma unroll
    for (int e = 0; e < 4; ++e) { v[e] += off; if (tid * 4 + e == P0) cs[8] = v[e]; }
    __syncthreads();
    const float c0 = cs[8];
#pragma unroll
    for (int e = 0; e < 4; ++e) ((float*)(lds + OFF_KX))[tid * 4 + e] = (c0 - v[e]) * (1.0f / SCALE);
}
}

__device__ __forceinline__ att::BlockRef fox_ref(const Params& p, int bh, int qb) {
    unsigned char* ws = p.ws; unsigned char* ys = (unsigned char*)p.out; const int b = bh / NH, h = bh % NH; att::BlockRef r;
    if (qb < 8) { const size_t row0 = (size_t)b * SEQ; r.Q = (const bf16_t*)(ws + W_QB) + (row0 + qb * 256) * FW + h * 128; r.K = (const bf16_t*)(ws + W_KB) + row0 * FW + h * 128;
        r.V = (const bf16_t*)(ws + W_VB) + row0 * FW + h * 128; r.O = (bf16_t*)(ws + W_SGF) + (row0 + qb * 256) * FW + h * 128; r.P0 = qb * 256; r.skv = SEQ; r.nvalid = 256; }
    else { const size_t row0 = (size_t)MP + b * DECS; r.Q = (const bf16_t*)(ws + W_QB) + row0 * FW + h * 128; r.K = (const bf16_t*)(ys + Y_KS) + (size_t)b * SKVS * FW + h * 128;
        r.V = (const bf16_t*)(ys + Y_VS) + (size_t)b * SKVS * FW + h * 128; r.O = (bf16_t*)(ws + W_SGF) + row0 * FW + h * 128; r.P0 = PAST; r.skv = SKVS; r.nvalid = DECS; }
    return r;
}
__device__ __forceinline__ void phase_fox(const Params& p, char* lds) {
    static constexpr unsigned char BINS[8][8] = { {0x07, 0x06, 0, 0, 0, 0, 0, 0}, {0x17, 0x16, 0, 0, 0, 0, 0, 0}, {0x27, 0x26, 0, 0, 0, 0, 0, 0},
        {0x05, 0x04, 0x08, 0, 0, 0, 0, 0}, {0x15, 0x14, 0x18, 0, 0, 0, 0, 0}, {0x25, 0x24, 0x28, 0, 0, 0, 0, 0},
        {0x03, 0x13, 0x23, 0x02, 0, 0, 0, 0}, {0x12, 0x22, 0x01, 0x11, 0x21, 0x00, 0x10, 0x20} };
    static constexpr unsigned char BINN[8] = {2, 2, 2, 3, 3, 3, 4, 8};
    att::Seam S;
    for (int vb = blockIdx.x; vb < 256; vb += gridDim.x) {
        const int tri = vb >> 3, bin = vb & 7, n = BINN[bin];
        int it = BINS[bin][0]; att::BlockRef cur = fox_ref(p, tri * 3 + (it >> 4), it & 15);
        att::prime(cur, lds, S);
        for (int k = 0; k < n; ++k) {
            att::BlockRef nxt = cur; int itn = it;
            if (k + 1 < n) { itn = BINS[bin][k + 1]; nxt = fox_ref(p, tri * 3 + (itn >> 4), itn & 15); }
            const int bh = tri * 3 + (it >> 4);
            att::build_kx(p, lds, bh / NH, bh % NH, (it & 15) == 8, cur.P0, (it & 15) == 8 ? SKVS : cur.P0 + 256);
            __syncthreads();
            att::block(cur, nxt, lds, S);
            cur = nxt; it = itn;
        }
        asm volatile("s_waitcnt vmcnt(0)" ::: "memory");
        __syncthreads();
    }
}

struct SchedS {
    int G, c; const char* MQ; const char* MKB;
    __device__ __forceinline__ bool next(int i, Unit& u) const {
        const int L = i * G + c; if (L >= 288) return false;
        u.lda = MW; u.ldb = MW; u.nt = 4; u.kind = 0;
        if (L < 256) { const int pm = L >> 2, h = L & 3; u.pm = pm; u.pn = h; u.aux = -1; u.A = MQ + ((size_t)pm * 256 * MW + h * 256) * 2; u.B = MKB + ((size_t)(pm >> 3) * 256 * MW + h * 256) * 2; }
        else { const int idx = L - 256, b = idx >> 2, h = idx & 3; u.pm = 64 + (b >> 2); u.pn = h; u.aux = b & 3; u.A = MQ + ((size_t)u.pm * 256 * MW + h * 256) * 2; u.B = MKB + ((size_t)(2048 + b * 256) * MW + h * 256) * 2; }
        return true;
    }
};
struct EpiS {
    bf16_t* P;
    __device__ __forceinline__ void operator()(const f32x4 (&acc)[2][2][4][2], const Unit& u, int wr, int wc, int fr, int fq, LAS unsigned char* lds) const {
        typedef float f32x2v __attribute__((ext_vector_type(2)));
        LAS f32x2v* X = (LAS f32x2v*)(lds + LDS_X);
        constexpr float C2 = 1.4426950408889634f * 0.0625f;
        float mw[2][4];
#pragma unroll
        for (int ai = 0; ai < 2; ++ai)
#pragma unroll
            for (int m = 0; m < 4; ++m) { float mx = -3.0e38f;
#pragma unroll
                for (int bj = 0; bj < 2; ++bj)
#pragma unroll
                    for (int n = 0; n < 2; ++n) { const f32x4 x = acc[ai][bj][m][n]; mx = fmaxf(mx, fmaxf(fmaxf(x[0], x[1]), fmaxf(x[2], x[3]))); }
                mx = fmaxf(mx, __shfl_xor(mx, 16)); mx = fmaxf(mx, __shfl_xor(mx, 32));
                float s = 0.f;
#pragma unroll
                for (int bj = 0; bj < 2; ++bj)
#pragma unroll
                    for (int n = 0; n < 2; ++n) { const f32x4 x = acc[ai][bj][m][n];
#pragma unroll
                        for (int j = 0; j < 4; ++j) s += __builtin_amdgcn_exp2f((x[j] - mx) * C2); }
                s += __shfl_xor(s, 16); s += __shfl_xor(s, 32);
                mw[ai][m] = mx;
                if (fq == 0) X[(wr * 128 + ai * 64 + m * 16 + fr) * 4 + wc] = (f32x2v){mx, s}; }
        asm volatile("s_waitcnt lgkmcnt(0)" ::: "memory"); __builtin_amdgcn_s_barrier(); asm volatile("" ::: "memory");
        const int lo = (u.aux < 0) ? 0 : u.aux * 64, hiR = (u.aux < 0) ? 256 : lo + 64;
#pragma unroll
        for (int ai = 0; ai < 2; ++ai)
#pragma unroll
            for (int m = 0; m < 4; ++m) { const int rl = ai * 128 + wr * 64 + m * 16 + fr; const LAS f32x2v* xr = X + (wr * 128 + ai * 64 + m * 16 + fr) * 4;
                const f32x2v a = xr[0], b = xr[1], c = xr[2], d = xr[3];
                const float M = fmaxf(fmaxf(a.x, b.x), fmaxf(c.x, d.x));
                const float Lsum = a.y * __builtin_amdgcn_exp2f((a.x - M) * C2) + b.y * __builtin_amdgcn_exp2f((b.x - M) * C2) + c.y * __builtin_amdgcn_exp2f((c.x - M) * C2) + d.y * __builtin_amdgcn_exp2f((d.x - M) * C2);
                const float rl_ = __builtin_amdgcn_rcpf(Lsum);
                if (rl >= lo && rl < hiR) { bf16_t* rp = P + (size_t)(u.pm * 256 + rl) * MW + u.pn * 256 + wc * 32 + fq * 4;
#pragma unroll
                    for (int bj = 0; bj < 2; ++bj)
#pragma unroll
                        for (int n = 0; n < 2; ++n) { const f32x4 x = acc[ai][bj][m][n]; float e[4];
#pragma unroll
                            for (int j = 0; j < 4; ++j) e[j] = __builtin_amdgcn_exp2f((x[j] - M) * C2) * rl_;
                            *(u32x2*)(rp + bj * 128 + n * 16) = (u32x2){cvtpk(e[0], e[1]), cvtpk(e[2], e[3])}; } } }
        (void)mw;
    }
};

__device__ __forceinline__ void phase_conv(const Params& p) {
    unsigned char* ws = p.ws; const bf16_t* U = (const bf16_t*)(ws + W_U); bf16_t* BG = (bf16_t*)(ws + W_BGS);
    const float* cw = p.in[I_CW]; const float* cb = p.in[I_CB]; const float* st = p.in[I_SCONV];
    const size_t n = (size_t)MROWS * (FW / 8), g0 = (size_t)blockIdx.x * 512 + otid(), gs = (size_t)gridDim.x * 512;
    for (size_t i = g0; i < n; i += gs) { const int row = (int)(i / (FW / 8)), ch = (int)(i % (FW / 8)) * 8;
        float u0[8], u1[8], u2[8], g[8];
        unpack8(*(const u32x4*)(U + (size_t)row * FW + ch), u2); unpack8(*(const u32x4*)(BG + (size_t)row * FW + ch), g);
        int t; const float* s0 = nullptr;
        if (row < MP) t = row & (SEQ - 1); else { const int rs = row - MP; t = rs & 63; s0 = st + (size_t)(rs >> 6) * 2 * FW + ch; }
        if (t >= 1) unpack8(*(const u32x4*)(U + (size_t)(row - 1) * FW + ch), u1);
        else {
#pragma unroll
            for (int e = 0; e < 8; ++e) u1[e] = s0 ? s0[FW + e] : 0.f; }
        if (t >= 2) unpack8(*(const u32x4*)(U + (size_t)(row - 2) * FW + ch), u0);
        else {
#pragma unroll
            for (int e = 0; e < 8; ++e) u0[e] = s0 ? s0[(size_t)t * FW + e] : 0.f; }
        float o[8];
#pragma unroll
        for (int e = 0; e < 8; ++e) o[e] = g[e] * (cw[ch + e] * u0[e] + cw[FW + ch + e] * u1[e] + cw[2 * FW + ch + e] * u2[e] + cb[ch + e]);
        *(u32x4*)(BG + (size_t)row * FW + ch) = (u32x4){cvtpk(o[0], o[1]), cvtpk(o[2], o[3]), cvtpk(o[4], o[5]), cvtpk(o[6], o[7])}; }
}

struct SchedPV {
    int G, c; const char* P; const char* VT;
    __device__ __forceinline__ bool next(int i, Unit& u) const {
        const int L = i * G + c; if (L >= 288) return false;
        u.lda = MW; u.ldb = 256; u.nt = 4; u.kind = 0;
        if (L < 256) { const int pm = L >> 2, h = L & 3; u.pm = pm; u.pn = h; u.aux = -1; u.A = P + ((size_t)pm * 256 * MW + h * 256) * 2; u.B = VT + ((size_t)(pm >> 3) * MW + h * 256) * 256 * 2; }
        else { const int idx = L - 256, b = idx >> 2, h = idx & 3; u.pm = 64 + (b >> 2); u.pn = h; u.aux = b & 3; u.A = P + ((size_t)u.pm * 256 * MW + h * 256) * 2; u.B = VT + ((size_t)(8 + b) * MW + h * 256) * 256 * 2; }
        return true;
    }
};
struct EpiPV {
    bf16_t* SGM;
    __device__ __forceinline__ void operator()(const f32x4 (&acc)[2][2][4][2], const Unit& u, int wr, int wc, int fr, int fq, LAS unsigned char*) const {
        const int lo = (u.aux < 0) ? 0 : u.aux * 64, hiR = (u.aux < 0) ? 256 : lo + 64;
#pragma unroll
        for (int ai = 0; ai < 2; ++ai)
#pragma unroll
            for (int m = 0; m < 4; ++m) { const int rl = ai * 128 + wr * 64 + m * 16 + fr;
                if (rl >= lo && rl < hiR) { bf16_t* rp = SGM + (size_t)(u.pm * 256 + rl) * MW + u.pn * 256 + wc * 32 + fq * 8;
#pragma unroll
                    for (int bj = 0; bj < 2; ++bj) { float g[8]; unpack8(*(const u32x4*)(rp + bj * 128), g); const f32x4 a = acc[ai][bj][m][0], b = acc[ai][bj][m][1];
                        *(u32x4*)(rp + bj * 128) = (u32x4){cvtpk(a[0] * g[0], a[1] * g[1]), cvtpk(a[2] * g[2], a[3] * g[3]), cvtpk(b[0] * g[4], b[1] * g[5]), cvtpk(b[2] * g[6], b[3] * g[7])}; } } }
    }
};
__device__ __forceinline__ void phase_prep2(const Params& p, char* smem) {
    float* tile = (float*)smem; unsigned char* ws = p.ws; const int G = gridDim.x, c = blockIdx.x; int ctr = 0;
    bf16_t* WTC = (bf16_t*)(ws + W_WTC);
    tr_matrix<0>(p.in[I_WMG], 6144, (bf16_t*)(ws + W_WTM), DM, 6144, DM, tile, ctr, G, c);
    tr_matrix<0>(p.in[I_WFO], DM, WTC, 4096, DM, FW, tile, ctr, G, c);
    tr_matrix<0>(p.in[I_WCO], DM, WTC + FW, 4096, DM, FW, tile, ctr, G, c);
    tr_matrix<0>(p.in[I_WMO], DM, WTC + 2 * FW, 4096, DM, MW, tile, ctr, G, c);
    tr_matrix<0>(p.in[I_WO], DM, (bf16_t*)(ws + W_WTO), DM, DM, DM, tile, ctr, G, c);
}

struct SchedE1 {
    int G, c; const char* XB; const char* WTM; const char* WTC; const char* AF; const char* AC; const char* AM;
    __device__ __forceinline__ bool next(int i, Unit& u) const {
        const int tr = i / 6, s = i - tr * 6; const int T = tr * G + c; if (T >= NPAN * 8) return false;
        const int pn = T / NPAN, pm = T % NPAN, br = s >> 1; u.pm = pm; u.pn = pn; u.kind = s; u.aux = br;
        if ((s & 1) == 0) { u.A = XB + (size_t)pm * 256 * DM * 2; u.B = WTM + ((size_t)br * DM + pn * 256) * DM * 2; u.lda = DM; u.ldb = DM; u.nt = DM / BK; }
        else { u.ldb = 4096; u.B = WTC + ((size_t)pn * 256 * 4096 + (br == 0 ? 0 : (br == 1 ? FW : 2 * FW))) * 2;
            if (br == 0) { u.A = AF + (size_t)pm * 256 * FW * 2; u.lda = FW; u.nt = FW / BK; } else if (br == 1) { u.A = AC + (size_t)pm * 256 * FW * 2; u.lda = FW; u.nt = FW / BK; }
            else { u.A = AM + (size_t)pm * 256 * MW * 2; u.lda = MW; u.nt = MW / BK; } }
        return true;
    }
};
struct EpiE1 {
    unsigned char* gs; unsigned char* msc; bf16_t* MB; const float* bmg;
    __device__ __forceinline__ void operator()(const f32x4 (&acc)[2][2][4][2], const Unit& u, int wr, int wc, int fr, int fq, LAS unsigned char*) const {
        int tid = threadIdx.x; asm volatile("" : "+v"(tid));
        const int s = u.kind, cl = wc * 32 + fq * 8;
        unsigned char* gsl = gs + (size_t)tid * 16; unsigned char* mscl = msc + (size_t)tid * 16;
        if ((s & 1) == 0) {
            const float* bp = bmg + u.aux * DM + u.pn * 256 + cl; f32x4 bv[2][2];
#pragma unroll
            for (int bj = 0; bj < 2; ++bj)
#pragma unroll
                for (int n = 0; n < 2; ++n) bv[bj][n] = *(const f32x4*)(bp + bj * 128 + n * 4);
#pragma unroll
            for (int ai = 0; ai < 2; ++ai)
#pragma unroll
                for (int bj = 0; bj < 2; ++bj)
#pragma unroll
                    for (int m = 0; m < 4; ++m) { f32x4 a = acc[ai][bj][m][0] + bv[bj][0], b = acc[ai][bj][m][1] + bv[bj][1];
#pragma unroll
                        for (int j = 0; j < 4; ++j) { a[j] = sigmoidf_(a[j]); b[j] = sigmoidf_(b[j]); }
                        *(u32x4*)(gsl + (((ai * 2 + bj) * 4 + m) * 8192)) = pack8u(a, b); asm volatile("" ::: "memory"); }
        } else {
#pragma unroll
            for (int ai = 0; ai < 2; ++ai)
#pragma unroll
                for (int bj = 0; bj < 2; ++bj)
#pragma unroll
                    for (int m = 0; m < 4; ++m) { const int k = (ai * 2 + bj) * 4 + m; float g[8]; unpack8(*(const u32x4*)(gsl + k * 8192), g);
                        f32x4 a = acc[ai][bj][m][0], b = acc[ai][bj][m][1];
#pragma unroll
                        for (int j = 0; j < 4; ++j) { a[j] *= g[j]; b[j] *= g[4 + j]; }
                        f32x4* mp = (f32x4*)(mscl + (k * 2) * 8192); f32x4* mq = (f32x4*)(mscl + (k * 2 + 1) * 8192);
                        if (s == 1) { *mp = a; *mq = b; }
                        else if (s == 3) { *mp = *mp + a; *mq = *mq + b; }
                        else { a = a + *mp; b = b + *mq; *(u32x4*)(MB + (size_t)(u.pm * 256 + ai * 128 + wr * 64 + m * 16 + fr) * DM + u.pn * 256 + bj * 128 + cl) = pack8u(a, b); }
                        if (m & 1) asm volatile("" ::: "memory"); }
        }
    }
};

struct SchedE2 {
    int G, c; const char* MB; const char* WTO;
    __device__ __forceinline__ bool next(int i, Unit& u) const {
        const int T = i * G + c; if (T >= NPAN * 8) return false;
        const int pn = T / NPAN, pm = T % NPAN; u.pm = pm; u.pn = pn; u.kind = 0; u.aux = 0; u.lda = DM; u.ldb = DM; u.nt = DM / BK;
        u.A = MB + (size_t)pm * 256 * DM * 2; u.B = WTO + (size_t)pn * 256 * DM * 2; return true;
    }
};
struct EpiE2 {
    float* out; const float* xp; const float* xs;
    __device__ __forceinline__ void operator()(const f32x4 (&acc)[2][2][4][2], const Unit& u, int wr, int wc, int fr, int fq, LAS unsigned char*) const {
        constexpr float ALPHA = 1.189207115002721f;
        const int cl = u.pn * 256 + wc * 32 + fq * 8;
#pragma unroll
        for (int ai = 0; ai < 2; ++ai)
#pragma unroll
            for (int m = 0; m < 4; ++m) { const int row = u.pm * 256 + ai * 128 + wr * 64 + m * 16 + fr; const float* xr; float* yr;
                if (row < MP) { xr = xp + (size_t)row * DM; yr = out + O_YP + (size_t)row * DM; } else { xr = xs + (size_t)(row - MP) * DM; yr = out + O_YS + (size_t)(row - MP) * DM; }
#pragma unroll
                for (int bj = 0; bj < 2; ++bj) { const int col = cl + bj * 128; const f32x4 x0 = *(const f32x4*)(xr + col), x1 = *(const f32x4*)(xr + col + 4);
                    *(f32x4*)(yr + col) = x0 * ALPHA + acc[ai][bj][m][0]; *(f32x4*)(yr + col + 4) = x1 * ALPHA + acc[ai][bj][m][1]; } }
    }
};

__device__ __forceinline__ void phase_ln(const Params& p) {
    const int tid = otid(), wid = tid >> 6, lane = tid & 63; const float* g = p.in[I_LNG]; const float* bb = p.in[I_LNB];
    for (int row = blockIdx.x * 8 + wid; row < MROWS; row += gridDim.x * 8) {
        float* yr = p.out + (row < MP ? O_YP + (size_t)row * DM : O_YS + (size_t)(row - MP) * DM);
        f32x4 v[8]; float s = 0.f;
#pragma unroll
        for (int i = 0; i < 8; ++i) { v[i] = *(const f32x4*)(yr + i * 256 + lane * 4); s += (v[i][0] + v[i][1]) + (v[i][2] + v[i][3]); }
#pragma unroll
        for (int o = 32; o >= 1; o >>= 1) s += __shfl_xor(s, o);
        const float mu = s * (1.0f / DM); float q = 0.f;
#pragma unroll
        for (int i = 0; i < 8; ++i) { const f32x4 d = v[i] - mu; q += (d[0] * d[0] + d[1] * d[1]) + (d[2] * d[2] + d[3] * d[3]); }
#pragma unroll
        for (int o = 32; o >= 1; o >>= 1) q += __shfl_xor(q, o);
        const float rstd = 1.0f / sqrtf(q * (1.0f / DM) + 1e-5f);
#pragma unroll
        for (int i = 0; i < 8; ++i) { const int col = i * 256 + lane * 4; const f32x4 gg = *(const f32x4*)(g + col), b4 = *(const f32x4*)(bb + col);
            *(f32x4*)(yr + col) = (v[i] - mu) * rstd * gg + b4; }
    }
}

#define GSYNC() do { __threadfence(); grid.sync(); __builtin_amdgcn_fence(__ATOMIC_ACQUIRE, "agent"); asm volatile("s_waitcnt vmcnt(0)" ::: "memory"); __syncthreads(); } while (0)
__global__ void __launch_bounds__(512) fwd_megakernel(Params p) {
    extern __shared__ __attribute__((aligned(16))) unsigned char smem[];
    cg::grid_group grid = cg::this_grid();
    LAS unsigned char* lds = (LAS unsigned char*)smem;
    unsigned char* ws = p.ws; unsigned char* ys = (unsigned char*)p.out;
    const int G = gridDim.x, c = blockIdx.x;

#ifndef PH
#define PH 0xFFFF
#endif
#if PH & 1
    phase_prep(p, (char*)smem);
#endif
    GSYNC();
#if PH & 2
    { SchedB S{G, c, (const char*)(ws + W_XB), (const char*)(ws + W_WTA)}; EpiB E{p.out, ws, p.in[I_FBF]}; gemm_phase(lds, S, E); }
#endif
    GSYNC();
#if PH & 4
    phase_fox(p, (char*)smem);
#endif
    __syncthreads();
#if PH & 8
    { SchedS S{G, c, (const char*)(ys + Y_MQ), (const char*)(ys + Y_MKB)}; EpiS E{(bf16_t*)(ws + W_P)}; gemm_phase(lds, S, E); }
#endif
#if PH & 16
    phase_conv(p);
#endif
    GSYNC();
#if PH & 32
    { SchedPV S{G, c, (const char*)(ws + W_P), (const char*)(ws + W_VT)}; EpiPV E{(bf16_t*)(ys + Y_SGM)}; gemm_phase(lds, S, E); }
#endif
    __syncthreads();
#if PH & 64
    phase_prep2(p, (char*)smem);
#endif
    GSYNC();
#if PH & 128
    { SchedE1 S{G, c, (const char*)(ws + W_XB), (const char*)(ws + W_WTM), (const char*)(ws + W_WTC), (const char*)(ws + W_SGF), (const char*)(ws + W_BGS), (const char*)(ys + Y_SGM)};
      EpiE1 E{ws + W_GS + (size_t)c * 131072, ws + W_MSC + (size_t)c * 262144, (bf16_t*)(ws + W_MB), p.in[I_BMG]}; gemm_phase(lds, S, E); }
#endif
    GSYNC();
#if PH & 256
    { SchedE2 S{G, c, (const char*)(ws + W_MB), (const char*)(ws + W_WTO)}; EpiE2 E{p.out, p.in[I_XP], p.in[I_XS]}; gemm_phase(lds, S, E); }
#endif
    GSYNC();
#if PH & 512
    phase_ln(p);
#endif
}

extern "C" void kernel_launch(void* const* d_in, const int* in_sizes, int n_in, void* d_out, int out_size, void* d_ws, size_t ws_size, hipStream_t stream) {
    static int grid_blocks = 0;
    if (grid_blocks == 0) {
        if (n_in != 22 || (size_t)out_size != O_END || ws_size < W_END) { fprintf(stderr, "kernel_launch: unexpected shapes (n_in %d, out %d, ws %zu, need %zu)\n", n_in, out_size, ws_size, (size_t)W_END); grid_blocks = -1; return; }
        int dev = 0, cus = 0, per_cu = 0;
        (void)hipGetDevice(&dev); (void)hipDeviceGetAttribute(&cus, hipDeviceAttributeMultiprocessorCount, dev);
        if (hipFuncSetAttribute((const void*)fwd_megakernel, hipFuncAttributeMaxDynamicSharedMemorySize, LDS_BYTES) != hipSuccess) { fprintf(stderr, "kernel_launch: hipFuncSetAttribute failed\n"); grid_blocks = -1; return; }
        if (hipOccupancyMaxActiveBlocksPerMultiprocessor(&per_cu, (const void*)fwd_megakernel, 512, LDS_BYTES) != hipSuccess || per_cu < 1) { fprintf(stderr, "kernel_launch: occupancy query says %d\n", per_cu); grid_blocks = -1; return; }
        int g = cus * per_cu; if (g > 256) g = 256; g &= ~7; if (g < 8) g = 8;
        grid_blocks = g;
    }
    if (grid_blocks < 0) return;
    Params p{};
    for (int i = 0; i < 22; ++i) p.in[i] = (const float*)d_in[i];
    p.out = (float*)d_out; p.ws = (unsigned char*)d_ws;
    void* args[] = {&p};
    hipError_t e = hipLaunchCooperativeKernel((const void*)fwd_megakernel, dim3(grid_blocks), dim3(512), args, LDS_BYTES, stream);
    if (e != hipSuccess) fprintf(stderr, "kernel_launch: cooperative launch failed: %s (grid %d)\n", hipGetErrorString(e), grid_blocks);
}
```

```cpp
#include <hip/hip_runtime.h>
#include <hip/hip_cooperative_groups.h>
#include <cstdio>
#include <cstdint>
namespace cg = cooperative_groups;

#define LAS __attribute__((address_space(3)))
typedef unsigned short bf16_t;
typedef short bf16x8 __attribute__((ext_vector_type(8)));
typedef short s16x4 __attribute__((ext_vector_type(4)));
typedef float f32x4 __attribute__((ext_vector_type(4)));
typedef float f32x16 __attribute__((ext_vector_type(16)));
typedef unsigned u32x4 __attribute__((ext_vector_type(4)));
typedef unsigned u32x2 __attribute__((ext_vector_type(2)));

constexpr int DM = 2048, MP = 16384, MS = 512, MM = 2048, SEQ = 2048, DECS = 64, PAST = 1024, NBATCH = 8;
constexpr int FW = 1536, MW = 1024, INW = 14348, NH = 12, SKVS = PAST + DECS;
constexpr int MROWS = MP + MS;
constexpr int NPAN = MROWS / 256;
constexpr int NTA = 57;
constexpr size_t O_YP = 0, O_YS = O_YP + (size_t)MP * DM, O_FKP = O_YS + (size_t)MS * DM, O_FVP = O_FKP + (size_t)MP * FW,
                 O_FLP = O_FVP + (size_t)MP * FW, O_CVP = O_FLP + (size_t)MP * NH, O_MKP = O_CVP + (size_t)NBATCH * 2 * FW,
                 O_MVP = O_MKP + (size_t)MM * MW, O_FKS = O_MVP + (size_t)MM * MW, O_FVS = O_FKS + (size_t)MS * FW,
                 O_FLS = O_FVS + (size_t)MS * FW, O_CVS = O_FLS + (size_t)MS * NH, O_END = O_CVS + (size_t)NBATCH * 2 * FW;
constexpr size_t Y_KS = 0, Y_VS = Y_KS + (size_t)NBATCH * SKVS * FW * 2, Y_MQ = Y_VS + (size_t)NBATCH * SKVS * FW * 2,
                 Y_SGM = Y_MQ + (size_t)MROWS * MW * 2, Y_MKB = Y_SGM + (size_t)MROWS * MW * 2, Y_END = Y_MKB + (size_t)4096 * MW * 2;
static_assert(Y_END <= (size_t)MP * DM * 4, "y scratch");
constexpr size_t W_XB = 0, W_WTA = W_XB + (size_t)(MROWS + MM) * DM * 2, W_QB = W_WTA + (size_t)16640 * DM * 2,
                 W_KB = W_QB + (size_t)(MROWS + 256) * FW * 2, W_VB = W_KB + (size_t)MP * FW * 2, W_U = W_VB + (size_t)MP * FW * 2,
                 W_SGF = W_U + (size_t)MROWS * FW * 2, W_BGS = W_SGF + (size_t)MROWS * FW * 2, W_VT = W_BGS + (size_t)MROWS * FW * 2,
                 W_END = W_VT + (size_t)16 * MW * 256 * 2;
constexpr size_t W_P = W_WTA, W_WTC = W_P + (size_t)MROWS * MW * 2, W_WTO = W_WTC + (size_t)DM * 4096 * 2, W_A1END = W_WTO + (size_t)DM * DM * 2;
static_assert(W_A1END <= W_QB, "alias 1");
constexpr size_t W_GS = W_QB, W_MSC = W_GS + (size_t)256 * 131072, W_MB = W_MSC + (size_t)256 * 262144, W_WTM = W_MB + (size_t)MROWS * DM * 2,
                 W_A2END = W_WTM + (size_t)6144 * DM * 2;
static_assert(W_A2END <= W_SGF, "alias 2");
static_assert(W_END <= (size_t)536870912, "workspace");

constexpr int LDS_STAGE = 131072, LDS_X = LDS_STAGE, LDS_BYTES = LDS_STAGE + 8192;

struct Params { const float* in[22]; float* out; unsigned char* ws; };
enum { I_XP = 0, I_XS, I_MEM, I_CFK, I_CFV, I_CFL, I_SCONV, I_CMK, I_CMV, I_WIN, I_FBF, I_CW, I_CB, I_WMKV, I_WFO, I_WCO, I_WMO, I_WMG, I_BMG, I_WO, I_LNG, I_LNB };

typedef __bf16 bf16x2_t __attribute__((ext_vector_type(2)));
typedef float f32x2_t __attribute__((ext_vector_type(2)));
__device__ __forceinline__ unsigned cvtpk(float lo, float hi) { const f32x2_t f = {lo, hi}; const bf16x2_t r = __builtin_convertvector(f, bf16x2_t); return __builtin_bit_cast(unsigned, r); }
__device__ __forceinline__ float bflo(unsigned w) { return __uint_as_float(w << 16); }
__device__ __forceinline__ float bfhi(unsigned w) { return __uint_as_float(w & 0xffff0000u); }
__device__ __forceinline__ float bf2f(bf16_t b) { return __uint_as_float(((unsigned)b) << 16); }
__device__ __forceinline__ u32x4 pack8u(f32x4 a, f32x4 b) { u32x4 w = {cvtpk(a[0], a[1]), cvtpk(a[2], a[3]), cvtpk(b[0], b[1]), cvtpk(b[2], b[3])}; return w; }
__device__ __forceinline__ bf16x8 pack8(f32x4 a, f32x4 b) { u32x4 w = pack8u(a, b); return *reinterpret_cast<bf16x8*>(&w); }
__device__ __forceinline__ float sigmoidf_(float x) { return __builtin_amdgcn_rcpf(1.f + __expf(-x)); }
__device__ __forceinline__ float siluf_(float x) { return x * sigmoidf_(x); }
__device__ __forceinline__ void unpack8(u32x4 w, float (&f)[8]) { f[0] = bflo(w.x); f[1] = bfhi(w.x); f[2] = bflo(w.y); f[3] = bfhi(w.y); f[4] = bflo(w.z); f[5] = bfhi(w.z); f[6] = bflo(w.w); f[7] = bfhi(w.w); }
__device__ __forceinline__ int otid() { int t = threadIdx.x; asm volatile("" : "+v"(t)); return t; }
__host__ __device__ __forceinline__ int perm32(int rho) { const int n = rho >> 4, i = rho & 15; return 8 * (i >> 2) + 4 * n + (i & 3); }
__host__ __device__ __forceinline__ int perm32inv(int l) { return 16 * ((l >> 2) & 1) + 4 * (l >> 3) + (l & 3); }

constexpr int BK = 64, HTB = 128 * BK * 2;
__device__ __forceinline__ int lds_byte(int r, int c) { const int st = (r >> 4) * 2 + (c >> 5), rr = r & 15, cc = c & 31, ob = rr * 64 + cc * 2; return st * 1024 + (ob ^ (((ob >> 9) & 1) << 5)); }
__device__ __forceinline__ void stage_rc(int b, int& R, int& C) { const int st = b / 1024, sb = b % 1024, swz = sb ^ (((sb >> 9) & 1) << 5); R = (st >> 1) * 16 + swz / 64; C = (st & 1) * 32 + (swz % 64) / 2; }

struct Unit { const char* A; const char* B; int lda, ldb, nt, kind, pm, pn, aux; };

template <class Sched, class Epi>
__device__ __forceinline__ void gemm_phase(LAS unsigned char* lds, const Sched& S, const Epi& E) {
    const int tid = otid(), wid = __builtin_amdgcn_readfirstlane(tid >> 6), lane = tid & 63, wr = wid >> 2, wc = wid & 3, fr = lane & 15, fq = lane >> 4;
    int sR0, sC0; stage_rc(tid * 16, sR0, sC0); const int sC2 = sC0 * 2;
    const size_t kstep = (size_t)(BK * 2);
    const unsigned ldsw = (unsigned)wid * 1024u;
    const int aoff = lds_byte(wr * 64 + fr, fq * 8), boff = lds_byte(wc * 32 + fr, fq * 8);
#define G_SA(b, h) (((b) * 2 + (h)) * HTB)
#define G_SB(b, h) ((4 + (b) * 2 + (h)) * HTB)
#define G_STAGE(bufoff, gbase, ld2) do { const unsigned v_ = (unsigned)sR0 * (unsigned)(ld2) + (unsigned)sC2; \
        __builtin_amdgcn_global_load_lds((const unsigned*)((const char*)(gbase) + v_), (LAS unsigned*)(lds + (bufoff) + ldsw), 16, 0, 0); \
        __builtin_amdgcn_global_load_lds((const unsigned*)((const char*)(gbase) + (size_t)(64u * (unsigned)(ld2)) + v_), (LAS unsigned*)(lds + (bufoff) + ldsw + 8192), 16, 0, 0); } while (0)
#define G_LDA(dst, b, h) do { _Pragma("unroll") for (int m = 0; m < 4; ++m) _Pragma("unroll") for (int k = 0; k < 2; ++k) dst[m][k] = *(const LAS bf16x8*)(lds + G_SA(b, h) + aoff + m * 2048 + k * 1024); } while (0)
#define G_LDB(dst, b, h) do { _Pragma("unroll") for (int n = 0; n < 2; ++n) _Pragma("unroll") for (int k = 0; k < 2; ++k) dst[n][k] = *(const LAS bf16x8*)(lds + G_SB(b, h) + boff + n * 2048 + k * 1024); } while (0)
#define G_MMA(ai, bj, At, Bt) do { __builtin_amdgcn_s_setprio(1); _Pragma("unroll") for (int m = 0; m < 4; ++m) _Pragma("unroll") for (int n = 0; n < 2; ++n) _Pragma("unroll") for (int k = 0; k < 2; ++k) \
        acc[ai][bj][m][n] = __builtin_amdgcn_mfma_f32_16x16x32_bf16(Bt[n][k], At[m][k], acc[ai][bj][m][n], 0, 0, 0); __builtin_amdgcn_s_setprio(0); } while (0)
#define G_WAIT_V(n) asm volatile("s_waitcnt vmcnt(" #n ")" ::: "memory")
#define G_WAIT_L(n) asm volatile("s_waitcnt lgkmcnt(" #n ")" ::: "memory")
#define G_BAR __builtin_amdgcn_s_barrier()
#define G_SCHED __builtin_amdgcn_sched_barrier(0)
    Unit cur, nxt; int ui = 0;
    if (!S.next(0, cur)) return;
    f32x4 acc[2][2][4][2];
#pragma unroll
    for (int a = 0; a < 2; ++a)
#pragma unroll
        for (int b = 0; b < 2; ++b)
#pragma unroll
            for (int m = 0; m < 4; ++m)
#pragma unroll
                for (int n = 0; n < 2; ++n) acc[a][b][m][n] = (f32x4){0.f, 0.f, 0.f, 0.f};
    bf16x8 At[4][2], B0[2][2], B1[2][2];
    const char* cA = cur.A; const char* cB = cur.B;
    int lA2 = cur.lda * 2, lB2 = cur.ldb * 2;
    size_t hA = (size_t)128 * lA2, hB = (size_t)128 * lB2;
    G_STAGE(G_SB(0, 0), cB, lB2); G_STAGE(G_SA(0, 0), cA, lA2); G_STAGE(G_SB(0, 1), cB + hB, lB2); G_STAGE(G_SA(0, 1), cA + hA, lA2);
    if (wr == 1) G_BAR;
    G_WAIT_V(4); G_BAR;
    G_STAGE(G_SB(1, 0), cB + kstep, lB2); G_STAGE(G_SA(1, 0), cA + kstep, lA2); G_STAGE(G_SB(1, 1), cB + hB + kstep, lB2);
    G_WAIT_V(6); G_BAR;
    for (;;) {
        const bool has_next = S.next(ui + 1, nxt);
        if (!has_next) nxt = cur;
        const char* nA = nxt.A; const char* nB = nxt.B;
        const int nlA2 = nxt.lda * 2, nlB2 = nxt.ldb * 2;
        const size_t nhA = (size_t)128 * nlA2, nhB = (size_t)128 * nlB2;
        const int nt = cur.nt;
        for (int t = 0; t < nt; t += 2) {
            const bool last = (t == nt - 2);
            const char* a1 = cA + (size_t)(t + 1) * kstep;
            const char* a2 = last ? nA : cA + (size_t)(t + 2) * kstep; const char* b2 = last ? nB : cB + (size_t)(t + 2) * kstep;
            const char* a3 = a2 + kstep; const char* b3 = b2 + kstep;
            const int xlA2 = last ? nlA2 : lA2, xlB2 = last ? nlB2 : lB2;
            const size_t xhA = last ? nhA : hA, xhB = last ? nhB : hB;
            G_LDB(B0, 0, 0); G_SCHED; G_LDA(At, 0, 0); G_STAGE(G_SA(1, 1), a1 + hA, lA2);
            G_WAIT_L(8); G_BAR; G_WAIT_L(0); G_MMA(0, 0, At, B0); G_BAR; G_SCHED;
            G_LDB(B1, 0, 1); G_STAGE(G_SB(0, 0), b2, xlB2);
            G_BAR; G_WAIT_L(0); G_MMA(0, 1, At, B1); G_BAR;
            G_LDA(At, 0, 1); G_STAGE(G_SA(0, 0), a2, xlA2);
            G_BAR; G_WAIT_L(0); G_MMA(1, 0, At, B0); G_BAR; G_SCHED;
            G_STAGE(G_SB(0, 1), b2 + xhB, xlB2);
            G_WAIT_V(6); G_BAR; G_MMA(1, 1, At, B1); G_BAR;
            G_LDB(B0, 1, 0); G_SCHED; G_LDA(At, 1, 0); G_STAGE(G_SA(0, 1), a2 + xhA, xlA2);
            G_WAIT_L(8); G_BAR; G_WAIT_L(0); G_MMA(0, 0, At, B0); G_BAR; G_SCHED;
            G_LDB(B1, 1, 1); G_STAGE(G_SB(1, 0), b3, xlB2);
            G_BAR; G_WAIT_L(0); G_MMA(0, 1, At, B1); G_BAR;
            G_LDA(At, 1, 1); G_STAGE(G_SA(1, 0), a3, xlA2);
            G_BAR; G_WAIT_L(0); G_MMA(1, 0, At, B0); G_BAR; G_SCHED;
            G_STAGE(G_SB(1, 1), b3 + xhB, xlB2);
            G_WAIT_V(6); G_BAR; G_MMA(1, 1, At, B1); G_BAR;
        }
        E(acc, cur, wr, wc, fr, fq, lds);
        if (!has_next) break;
#pragma unroll
        for (int a = 0; a < 2; ++a)
#pragma unroll
            for (int b = 0; b < 2; ++b)
#pragma unroll
                for (int m = 0; m < 4; ++m)
#pragma unroll
                    for (int n = 0; n < 2; ++n) acc[a][b][m][n] = (f32x4){0.f, 0.f, 0.f, 0.f};
        cur = nxt; cA = nA; cB = nB; lA2 = nlA2; lB2 = nlB2; hA = nhA; hB = nhB; ++ui;
    }
    G_WAIT_V(0);
    if (wr == 0) G_BAR;
    G_BAR;
#undef G_STAGE
#undef G_LDA
#undef G_LDB
#undef G_MMA
}

__device__ __forceinline__ void conv_rows(const float* src, bf16_t* dst, size_t n8, size_t g0, size_t gs) {
    size_t i = g0;
    for (; i + 3 * gs < n8; i += 4 * gs) { f32x4 a[4], b[4];
#pragma unroll
        for (int u = 0; u < 4; ++u) { a[u] = *(const f32x4*)(src + (i + u * gs) * 8); b[u] = *(const f32x4*)(src + (i + u * gs) * 8 + 4); }
#pragma unroll
        for (int u = 0; u < 4; ++u) *(u32x4*)(dst + (i + u * gs) * 8) = pack8u(a[u], b[u]); }
    for (; i < n8; i += gs) { const f32x4 a = *(const f32x4*)(src + i * 8), b = *(const f32x4*)(src + i * 8 + 4); *(u32x4*)(dst + i * 8) = pack8u(a, b); }
}
__device__ __forceinline__ int colmapA(int lc) {
    const int t = lc >> 8, o = lc & 255;
    if (t < 18) return lc;
    if (t < 24) return 4620 + (lc - 4608);
    if (t < 36) { const int i = t - 24; return (o < 128) ? 7692 + 128 * i + o : 9228 + 128 * i + (o - 128); }
    if (t < 48) { const int i = t - 36; return (o < 128) ? 6156 + 128 * i + o : 10764 + 128 * i + (o - 128); }
    if (t < 52) return 12300 + (lc - 48 * 256);
    if (t < 56) return 13324 + (lc - 52 * 256);
    return (o < 12) ? 4608 + o : -1;
}
constexpr int TRS = 132;
template <int MODE>
__device__ __forceinline__ void tr_tile(const float* src, int sld, bf16_t* dst, int dld, int j0, int k0, float* tile) {
    const int tid = otid();
    { const int jq = tid & 31, kk0 = tid >> 5; const int j = j0 + jq * 4; int col;
      if (MODE == 2) col = j; else { const int lc = (j & ~31) + perm32(j & 31); col = (MODE == 1) ? colmapA(lc) : lc; }
      f32x4 v[8];
#pragma unroll
      for (int i = 0; i < 8; ++i) { const int kk = kk0 + 16 * i; v[i] = (col >= 0) ? *(const f32x4*)(src + (size_t)(k0 + kk) * sld + col) : (f32x4){0.f, 0.f, 0.f, 0.f}; }
#pragma unroll
      for (int i = 0; i < 8; ++i) *(f32x4*)(tile + (kk0 + 16 * i) * TRS + jq * 4) = v[i]; }
    __syncthreads();
    { const int jj = tid & 127, kc = tid >> 7; bf16_t* dp = dst + (size_t)(j0 + jj) * dld + k0 + kc * 32;
#pragma unroll
      for (int q = 0; q < 4; ++q) { float v[8];
#pragma unroll
          for (int e = 0; e < 8; ++e) v[e] = tile[(kc * 32 + q * 8 + e) * TRS + jj];
          *(u32x4*)(dp + q * 8) = (u32x4){cvtpk(v[0], v[1]), cvtpk(v[2], v[3]), cvtpk(v[4], v[5]), cvtpk(v[6], v[7])}; } }
    __syncthreads();
}
template <int MODE>
__device__ __forceinline__ void tr_matrix(const float* src, int sld, bf16_t* dst, int dld, int nj, int nk, float* tile, int& ctr, int G, int c) {
    const int tk = nk / 128, total = (nj / 128) * tk;
    int t0 = (c - ctr % G) % G; if (t0 < 0) t0 += G;
    for (int t = t0; t < total; t += G) tr_tile<MODE>(src, sld, dst, dld, (t / tk) * 128, (t % tk) * 128, tile);
    ctr += total;
}

__device__ __forceinline__ void phase_prep(const Params& p, char* smem) {
    float* tile = (float*)smem;
    unsigned char* ws = p.ws; unsigned char* ys = (unsigned char*)p.out;
    const int G = gridDim.x, c = blockIdx.x; const size_t g0 = (size_t)c * 512 + otid(), gs = (size_t)G * 512;
    bf16_t* XB = (bf16_t*)(ws + W_XB);
    int ctr = 0;
    tr_matrix<1>(p.in[I_WIN], INW, (bf16_t*)(ws + W_WTA), DM, NTA * 256, DM, tile, ctr, G, c);
    tr_matrix<0>(p.in[I_WMKV], 2048, (bf16_t*)(ws + W_WTA) + (size_t)NTA * 256 * DM, DM, 2048, DM, tile, ctr, G, c);
    for (int b = 0; b < NBATCH; ++b)
        tr_matrix<0>(p.in[I_CMV] + (size_t)b * 256 * MW, MW, (bf16_t*)(ws + W_VT) + (size_t)(8 + b) * MW * 256, 256, MW, 256, tile, ctr, G, c);
    conv_rows(p.in[I_XP], XB, (size_t)MP * DM / 8, g0, gs);
    conv_rows(p.in[I_XS], XB + (size_t)MP * DM, (size_t)MS * DM / 8, g0, gs);
    conv_rows(p.in[I_MEM], XB + (size_t)MROWS * DM, (size_t)MM * DM / 8, g0, gs);
    conv_rows(p.in[I_CMK], (bf16_t*)(ys + Y_MKB) + (size_t)2048 * MW, (size_t)2048 * MW / 8, g0, gs);
    {
        bf16_t* KS = (bf16_t*)(ys + Y_KS); bf16_t* VS = (bf16_t*)(ys + Y_VS); const float* ck = p.in[I_CFK]; const float* cv = p.in[I_CFV];
        const size_t n8 = (size_t)NBATCH * PAST * FW / 8;
        for (size_t i = g0; i < n8; i += gs) { const size_t e = i * 8, row = e / FW, col = e % FW, b = row / PAST, pp = row % PAST; const size_t d = ((b * SKVS + pp) * FW + col);
            *(u32x4*)(KS + d) = pack8u(*(const f32x4*)(ck + e), *(const f32x4*)(ck + e + 4)); *(u32x4*)(VS + d) = pack8u(*(const f32x4*)(cv + e), *(const f32x4*)(cv + e + 4)); }
    }
}

enum { KQ = 0, KK, KV, KGF, KCH, KBG, KMQ, KGM, KF, KMK, KMV };
struct SchedB {
    int G, c; const char* XB; const char* WTA;
    __device__ __forceinline__ bool next(int i, Unit& u) const {
        const int NU1 = NPAN * NTA, NU2 = 64; const long L = (long)i * G + c; if (L >= NU1 + NU2) return false;
        int pm, pn;
        if (L < NU1) { int wgid = (int)L; const int nwg = NU1; { const int q = nwg / 8, r = nwg % 8, xcd = wgid % 8, off = wgid / 8; wgid = (xcd < r ? xcd * (q + 1) : r * (q + 1) + (xcd - r) * q) + off; }
            const int nig = 8 * NTA, gid = wgid / nig, fm = gid * 8, gsz = (NPAN - fm) < 8 ? (NPAN - fm) : 8; pm = fm + ((wgid % nig) % gsz); pn = (wgid % nig) / gsz; }
        else { const int l2 = (int)L - NU1; pm = NPAN + (l2 & 7); pn = NTA + (l2 >> 3); }
        u.pm = pm; u.pn = pn; u.lda = DM; u.ldb = DM; u.nt = DM / BK;
        u.A = XB + (size_t)pm * 256 * DM * 2; u.B = WTA + (size_t)pn * 256 * DM * 2;
        int kind, aux;
        if (pn < 6) { kind = KQ; aux = pn; } else if (pn < 12) { kind = KK; aux = pn - 6; } else if (pn < 18) { kind = KV; aux = pn - 12; } else if (pn < 24) { kind = KGF; aux = pn - 18; }
        else if (pn < 36) { kind = KCH; aux = pn - 24; } else if (pn < 48) { kind = KBG; aux = pn - 36; } else if (pn < 52) { kind = KMQ; aux = pn - 48; } else if (pn < 56) { kind = KGM; aux = pn - 52; }
        else if (pn < 57) { kind = KF; aux = 0; } else if (pn < 61) { kind = KMK; aux = pn - 57; } else { kind = KMV; aux = pn - 61; }
        u.kind = kind; u.aux = aux; return true;
    }
};
struct EpiB {
    float* out; unsigned char* ws; const float* fbf;
    __device__ __forceinline__ void operator()(const f32x4 (&acc)[2][2][4][2], const Unit& u, int wr, int wc, int fr, int fq, LAS unsigned char*) const {
        unsigned char* ys = (unsigned char*)out;
        const int kind = u.kind, aux = u.aux, rbase = u.pm * 256 + wr * 64 + fr, cl = wc * 32 + fq * 8;
        const bool prompt = u.pm < 64;
        if (kind == KQ || kind == KGF || kind == KMQ || kind == KGM) {
            bf16_t* dst; int ld;
            if (kind == KQ) { dst = (bf16_t*)(ws + W_QB); ld = FW; } else if (kind == KGF) { dst = (bf16_t*)(ws + W_SGF); ld = FW; } else if (kind == KMQ) { dst = (bf16_t*)(ys + Y_MQ); ld = MW; } else { dst = (bf16_t*)(ys + Y_SGM); ld = MW; }
            const bool act = (kind == KGF || kind == KGM);
#pragma unroll
            for (int ai = 0; ai < 2; ++ai)
#pragma unroll
                for (int m = 0; m < 4; ++m) { bf16_t* rp = dst + (size_t)(rbase + ai * 128 + m * 16) * ld + aux * 256 + cl;
#pragma unroll
                    for (int bj = 0; bj < 2; ++bj) { f32x4 a = acc[ai][bj][m][0], b = acc[ai][bj][m][1];
                        if (act) {
#pragma unroll
                            for (int j = 0; j < 4; ++j) { a[j] = siluf_(a[j]); b[j] = siluf_(b[j]); } }
                        *(u32x4*)(rp + bj * 128) = pack8u(a, b); } }
        } else if (kind == KK || kind == KV) {
#pragma unroll
            for (int ai = 0; ai < 2; ++ai)
#pragma unroll
                for (int m = 0; m < 4; ++m) { const int row = rbase + ai * 128 + m * 16; float* fo; bf16_t* bo;
                    if (prompt) { fo = out + (kind == KK ? O_FKP : O_FVP) + (size_t)row * FW; bo = (bf16_t*)(ws + (kind == KK ? W_KB : W_VB)) + (size_t)row * FW; }
                    else { const int rs = row - MP; fo = out + (kind == KK ? O_FKS : O_FVS) + (size_t)rs * FW; bo = (bf16_t*)(ys + (kind == KK ? Y_KS : Y_VS)) + ((size_t)(rs >> 6) * SKVS + PAST + (rs & 63)) * FW; }
#pragma unroll
                    for (int bj = 0; bj < 2; ++bj) { const int col = aux * 256 + bj * 128 + cl; const f32x4 a = acc[ai][bj][m][0], b = acc[ai][bj][m][1];
                        *(f32x4*)(fo + col) = a; *(f32x4*)(fo + col + 4) = b; *(u32x4*)(bo + col) = pack8u(a, b); } }
        } else if (kind == KCH) {
            bf16_t* U = (bf16_t*)(ws + W_U);
#pragma unroll
            for (int ai = 0; ai < 2; ++ai)
#pragma unroll
                for (int m = 0; m < 4; ++m) { const int row = rbase + ai * 128 + m * 16; const int ch = aux * 128 + cl;
                    const f32x4 a = acc[ai][0][m][0] * acc[ai][1][m][0], b = acc[ai][0][m][1] * acc[ai][1][m][1];
                    *(u32x4*)(U + (size_t)row * FW + ch) = pack8u(a, b);
                    float* tp = nullptr;
                    if (prompt) { const int s = row & (SEQ - 1); if (s >= SEQ - 2) tp = out + O_CVP + ((size_t)(row >> 11) * 2 + (s - (SEQ - 2))) * FW + ch; }
                    else { const int rs = row - MP, t = rs & 63; if (t >= DECS - 2) tp = out + O_CVS + ((size_t)(rs >> 6) * 2 + (t - (DECS - 2))) * FW + ch; }
                    if (tp) { *(f32x4*)tp = a; *(f32x4*)(tp + 4) = b; } }
        } else if (kind == KBG) {
            bf16_t* BG = (bf16_t*)(ws + W_BGS);
#pragma unroll
            for (int ai = 0; ai < 2; ++ai)
#pragma unroll
                for (int m = 0; m < 4; ++m) { const int row = rbase + ai * 128 + m * 16; const int ch = aux * 128 + cl; f32x4 a, b;
#pragma unroll
                    for (int j = 0; j < 4; ++j) { a[j] = acc[ai][0][m][0][j] * siluf_(acc[ai][1][m][0][j]); b[j] = acc[ai][0][m][1][j] * siluf_(acc[ai][1][m][1][j]); }
                    *(u32x4*)(BG + (size_t)row * FW + ch) = pack8u(a, b); }
        } else if (kind == KF) {
            if (wc == 0 && fq < 2) {
#pragma unroll
                for (int ai = 0; ai < 2; ++ai)
#pragma unroll
                    for (int m = 0; m < 4; ++m) { const int row = rbase + ai * 128 + m * 16; float* lp = prompt ? out + O_FLP + (size_t)row * NH : out + O_FLS + (size_t)(row - MP) * NH;
#pragma unroll
                        for (int n = 0; n < 2; ++n)
#pragma unroll
                            for (int j = 0; j < 4; ++j) { const int col = fq * 8 + n * 4 + j; if (col < NH) { const float x = acc[ai][0][m][n][j] + fbf[col];
                                lp[col] = (x < 0.f) ? x - log1pf(expf(x)) : -log1pf(expf(-x)); } } }
            }
        } else {
#pragma unroll
            for (int ai = 0; ai < 2; ++ai)
#pragma unroll
                for (int m = 0; m < 4; ++m) { const int rm = rbase + ai * 128 + m * 16 - MROWS; float* fo = out + (kind == KMK ? O_MKP : O_MVP) + (size_t)rm * MW;
#pragma unroll
                    for (int bj = 0; bj < 2; ++bj) { const int col = aux * 256 + bj * 128 + cl; const f32x4 a = acc[ai][bj][m][0], b = acc[ai][bj][m][1];
                        *(f32x4*)(fo + col) = a; *(f32x4*)(fo + col + 4) = b;
                        if (kind == KMK) { *(u32x4*)((bf16_t*)(ys + Y_MKB) + (size_t)rm * MW + col) = pack8u(a, b); }
                        else { bf16_t* vt = (bf16_t*)(ws + W_VT) + (size_t)(rm >> 8) * MW * 256 + (rm & 255); const u32x4 w = pack8u(a, b); const unsigned ww[4] = {w.x, w.y, w.z, w.w};
#pragma unroll
                            for (int e = 0; e < 8; ++e) { const int lc = col + e; const int rp = (lc & ~31) + perm32inv(lc & 31); vt[(size_t)rp * 256] = (bf16_t)((e & 1) ? (ww[e >> 1] >> 16) : (ww[e >> 1] & 0xffffu)); } } } }
        }
    }
};

namespace att {
constexpr int D = 128, LDQ = FW, NW = 8, QBLK = 32, KVBLK = 64, QB = NW * QBLK;
constexpr int SHM_V = KVBLK * D * 2, SHM_K = KVBLK * D * 2;
constexpr int OFF_LI = 2 * SHM_V + 2 * SHM_K, OFF_KX = OFF_LI + NW * 64 * 4, OFF_CS = OFF_KX + 2048 * 4, OFF_END = OFF_CS + 256;
static_assert(OFF_END <= LDS_STAGE, "attention LDS");
constexpr float SCALE = 0.08838834764831845f, THR = 8.f;
#define KSWZ(row, colB) ((row) * 256 + ((colB) ^ (((row) & 7) << 4)))
#define SBAR() __builtin_amdgcn_sched_barrier(0)
__device__ __forceinline__ int v_st(int k, int c) { const int kk = (k & ~0xC) | ((k & 4) << 1) | ((k & 8) >> 1); return ((kk >> 3) * 4 + (c >> 5)) * 512 + ((kk & 7) * 32 + (c & 31)) * 2; }
__device__ __forceinline__ int v_rd_base(int lane) { return ((lane & 3) << 3) | (((lane >> 2) & 3) << 6) | (((lane >> 4) & 1) << 5) | (((lane >> 5) & 1) << 8); }
constexpr int v_rd_off(int d0, int ks, int half) { return d0 * 512 + ks * 4096 + half * 2048; }
__device__ __forceinline__ int crow(int r, int hi) { return (r & 3) + 8 * (r >> 2) + 4 * hi; }
__device__ __forceinline__ bf16x8 load8(const bf16_t* p) { return *reinterpret_cast<const bf16x8*>(p); }
__device__ __forceinline__ void mask_tile(f32x16& p0, f32x16& p1, int dq, unsigned W) {
    const float NEG = -__builtin_inff();
#pragma unroll
    for (int r = 0; r < 16; ++r) { const int c = (r & 3) + 8 * (r >> 2); if ((unsigned)(dq - c) >= W) p0[r] = NEG; if ((unsigned)(dq - c - 32) >= W) p1[r] = NEG; }
}
__device__ __forceinline__ void partialSM(f32x16& p0, f32x16& p1, float& m_reg, float& mn, float& alpha) {
    float pmax = p0[0]; for (int r = 1; r < 16; ++r) pmax = fmaxf(pmax, p0[r]); for (int r = 0; r < 16; ++r) pmax = fmaxf(pmax, p1[r]);
    { auto rr = __builtin_amdgcn_permlane32_swap(__float_as_uint(pmax), __float_as_uint(pmax), false, false); pmax = fmaxf(__uint_as_float(rr[0]), __uint_as_float(rr[1])); }
    constexpr float C2 = 1.4426950408889634f * SCALE;
    if (__builtin_expect(__all((pmax - m_reg) * SCALE <= THR), 1)) { mn = m_reg; alpha = 1.f; }
    else { mn = fmaxf(m_reg, pmax); alpha = __builtin_amdgcn_exp2f((m_reg - mn) * C2); m_reg = mn; }
    const float mnL = -mn * C2;
    for (int r = 0; r < 16; ++r) p0[r] = fmaf(p0[r], C2, mnL); for (int r = 0; r < 16; ++r) p1[r] = fmaf(p1[r], C2, mnL);
    for (int r = 0; r < 16; ++r) p0[r] = __builtin_amdgcn_exp2f(p0[r]);
}
__device__ __forceinline__ void finishSM(f32x16& p0, f32x16& p1, float alpha, float& l_reg, bf16x8& pa0, bf16x8& pa1, bf16x8& pa2, bf16x8& pa3) {
    for (int r = 0; r < 16; ++r) p1[r] = __builtin_amdgcn_exp2f(p1[r]);
    float ps = 0; for (int r = 0; r < 16; ++r) ps += p0[r]; for (int r = 0; r < 16; ++r) ps += p1[r];
    { auto rr = __builtin_amdgcn_permlane32_swap(__float_as_uint(ps), __float_as_uint(ps), false, false); ps = __uint_as_float(rr[0]) + __uint_as_float(rr[1]); }
    l_reg = l_reg * alpha + ps;
#define PK4(P, B_, OUT) do { unsigned a0 = cvtpk(P[B_+0], P[B_+1]), a1 = cvtpk(P[B_+2], P[B_+3]);                          \
        unsigned b0 = cvtpk(P[B_+4], P[B_+5]), b1 = cvtpk(P[B_+6], P[B_+7]);                                             \
        auto r0 = __builtin_amdgcn_permlane32_swap(a0, b0, false, false); auto r1 = __builtin_amdgcn_permlane32_swap(a1, b1, false, false); \
        u32x4 w = {r0[0], r1[0], r0[1], r1[1]}; OUT = *reinterpret_cast<bf16x8*>(&w); } while (0)
    PK4(p0, 0, pa0); PK4(p0, 8, pa1); PK4(p1, 0, pa2); PK4(p1, 8, pa3);
#undef PK4
}
template <int KB>
__device__ __forceinline__ void qkt(f32x16& p0, f32x16& p1, const char* K_lds, int r32, int hi, const bf16x8* qr, const float* bt) {
#pragma unroll
    for (int g = 0; g < 4; ++g) { const f32x4 a = *(const f32x4*)(bt + 8 * g), b = *(const f32x4*)(bt + 32 + 8 * g);
        p0[4 * g] = a[0]; p0[4 * g + 1] = a[1]; p0[4 * g + 2] = a[2]; p0[4 * g + 3] = a[3]; p1[4 * g] = b[0]; p1[4 * g + 1] = b[1]; p1[4 * g + 2] = b[2]; p1[4 * g + 3] = b[3]; }
    const char* kb[4];
#pragma unroll
    for (int dd = 0; dd < 4; ++dd) kb[dd] = K_lds + KB * SHM_K + KSWZ(r32, (dd * 16 + hi * 8) * 2);
#pragma unroll
    for (int d0 = 0; d0 < 8; ++d0) { const char* a = kb[d0 & 3] + (d0 >> 2) * 128;
        bf16x8 b0 = *reinterpret_cast<const bf16x8*>(a);
        bf16x8 b1 = *reinterpret_cast<const bf16x8*>(a + 32 * 256);
        p0 = __builtin_amdgcn_mfma_f32_32x32x16_bf16(b0, qr[d0], p0, 0, 0, 0);
        p1 = __builtin_amdgcn_mfma_f32_32x32x16_bf16(b1, qr[d0], p1, 0, 0, 0); }
}
template <int VB>
__device__ __forceinline__ void pv_tile(f32x16* o, int vb0, bf16x8 pa0, bf16x8 pa1, bf16x8 pa2, bf16x8 pa3) {
#define TRRD(dst, off) asm volatile("ds_read_b64_tr_b16 %0, %1 offset:%2" : "=&v"(dst) : "v"(vb0), "i"(off) : "memory")
#define PV_D0(d0) do { s16x4 l0, l1, l2, l3, h0, h1, h2, h3; constexpr int b_ = VB * SHM_V + v_rd_off(d0, 0, 0); \
        TRRD(l0, b_); TRRD(h0, b_ + 2048); TRRD(l1, b_ + 4096); TRRD(h1, b_ + 6144); TRRD(l2, b_ + 8192); TRRD(h2, b_ + 10240); TRRD(l3, b_ + 12288); TRRD(h3, b_ + 14336); \
        asm volatile("s_waitcnt lgkmcnt(0)" ::: "memory"); SBAR(); \
        o[d0] = __builtin_amdgcn_mfma_f32_32x32x16_bf16(pa0, (bf16x8){l0[0], l0[1], l0[2], l0[3], h0[0], h0[1], h0[2], h0[3]}, o[d0], 0, 0, 0);   \
        o[d0] = __builtin_amdgcn_mfma_f32_32x32x16_bf16(pa1, (bf16x8){l1[0], l1[1], l1[2], l1[3], h1[0], h1[1], h1[2], h1[3]}, o[d0], 0, 0, 0);   \
        o[d0] = __builtin_amdgcn_mfma_f32_32x32x16_bf16(pa2, (bf16x8){l2[0], l2[1], l2[2], l2[3], h2[0], h2[1], h2[2], h2[3]}, o[d0], 0, 0, 0);   \
        o[d0] = __builtin_amdgcn_mfma_f32_32x32x16_bf16(pa3, (bf16x8){l3[0], l3[1], l3[2], l3[3], h3[0], h3[1], h3[2], h3[3]}, o[d0], 0, 0, 0); } while (0)
    PV_D0(0); PV_D0(1); PV_D0(2); PV_D0(3);
#undef PV_D0
#undef TRRD
}
struct BlockRef { const bf16_t* Q; const bf16_t* K; const bf16_t* V; bf16_t* O; int P0, skv, nvalid; };
struct Seam { bf16x8 qr[8]; bf16x8 st_v0, st_v1, st_k0, st_k1; };
#define ROW(p, k0, rr) ((p) + (size_t)((k0) + (rr)) * LDQ + sc)
#define VMW() asm volatile("s_waitcnt vmcnt(0)" ::: "memory")
#define VMWN(n) asm volatile("s_waitcnt vmcnt(%0)" :: "i"(n) : "memory")
#define SLOAD_H(Kp, Vp, k0) do { S.st_v0 = load8(ROW(Vp, k0, sr)); S.st_v1 = load8(ROW(Vp, k0, 32 + sr)); S.st_k0 = load8(ROW(Kp, k0, sr)); S.st_k1 = load8(ROW(Kp, k0, 32 + sr)); } while (0)
#define SWRITE_HK(bf) do { *(bf16x8*)(K_lds + (bf) * SHM_K + kws) = S.st_k0; *(bf16x8*)(K_lds + (bf) * SHM_K + kws + 32 * 256) = S.st_k1; } while (0)
#define SWRITE_HV(bf) do { *(bf16x8*)(V_lds + (bf) * SHM_V + vst0) = S.st_v0; *(bf16x8*)(V_lds + (bf) * SHM_V + vst1) = S.st_v1; } while (0)
#define SWRITE_H(bf) do { SWRITE_HV(bf); SWRITE_HK(bf); } while (0)
__device__ __forceinline__ void prime(const BlockRef& cur, char* lds, Seam& S) {
    const int tid = otid(), wid = __builtin_amdgcn_readfirstlane(tid >> 6), lane = tid & 63, r32 = lane & 31, hi = lane >> 5;
    const int sr = tid >> 4, sc = (tid & 15) * 8, kws = KSWZ(sr, sc * 2); char* K_lds = lds + 2 * SHM_V;
    for (int d0 = 0; d0 < 8; ++d0) S.qr[d0] = load8(cur.Q + (size_t)(wid * QBLK + r32) * LDQ + d0 * 16 + hi * 8);
    SLOAD_H(cur.K, cur.V, 0); VMW(); SWRITE_HK(0);
    __syncthreads();
}
__device__ __forceinline__ void block(const BlockRef& cur, const BlockRef& nxt, char* lds, Seam& S) {
    const int tid = otid(), wid = __builtin_amdgcn_readfirstlane(tid >> 6), lane = tid & 63, r32 = lane & 31, hi = lane >> 5;
    constexpr int W = 1 << 24;
    int j_hi = (cur.P0 + QB - 1) / KVBLK + 1; if (j_hi > cur.skv / KVBLK) j_hi = cur.skv / KVBLK;
    const int NT = j_hi;
    const int qlo = cur.P0 + wid * QBLK, qm = qlo + r32 - 4 * hi;
    char* V_lds = lds; char* K_lds = lds + 2 * SHM_V; const float* KXf = (const float*)(lds + OFF_KX) + 4 * hi;
    float* wsl = (float*)(lds + OFF_LI) + wid * 64; float* li_l = wsl, * al_l = wsl + 32;
    float m_reg = -1e30f, l_reg = 0; f32x16 o[4] = {};
    const int sr = tid >> 4, sc = (tid & 15) * 8, vst0 = v_st(sr, sc), vst1 = v_st(32 + sr, sc), kws = KSWZ(sr, sc * 2);
    const int vb0 = (int)(uintptr_t)V_lds + v_rd_base(lane);
    const bf16_t* Kh = cur.K; const bf16_t* Vh = cur.V;
#define RESC(a) do { if (__any((a) < 1.f)) { if (hi == 0) al_l[r32] = (a); asm volatile("s_waitcnt lgkmcnt(0)" ::: "memory");              \
                     for (int d_ = 0; d_ < 4; ++d_) for (int r = 0; r < 16; ++r) o[d_][r] *= al_l[crow(r, hi)]; } } while (0)
#define KBASE(t) ((t) * KVBLK)
#define MASKT(P0_, P1_, t) do { const int kb_ = KBASE(t); if (kb_ + KVBLK - 1 > qlo) mask_tile(P0_, P1_, qm - kb_, (unsigned)W); } while (0)
#define SEAM_K0() do { VMWN(8); SWRITE_HK(0); SBAR(); } while (0)
    f32x16 pA0, pA1, pB0, pB1; float mnA, mnB, alA, alB; bf16x8 pa0, pa1, pa2, pa3;
    SWRITE_HV(0); SBAR();
    if (NT > 1) { SLOAD_H(Kh, Vh, KBASE(1)); }
    SBAR(); qkt<0>(pA0, pA1, K_lds, r32, hi, S.qr, KXf + KBASE(0));
    MASKT(pA0, pA1, 0); partialSM(pA0, pA1, m_reg, mnA, alA);
    if (NT > 1) { VMW(); SWRITE_H(1); }
    __syncthreads();
#define HALF_STEP(PX0, PX1, mnX, alX, PY0, PY1, alY, t, KB, VB, SB) do {                                                      \
        SBAR(); qkt<KB>(PX0, PX1, K_lds, r32, hi, S.qr, KXf + KBASE(t));                                              \
        finishSM(PY0, PY1, alY, l_reg, pa0, pa1, pa2, pa3); SBAR();                                                           \
        if ((t) + 1 < NT) { SLOAD_H(Kh, Vh, KBASE((t) + 1)); SBAR(); }                                                        \
        pv_tile<VB>(o, vb0, pa0, pa1, pa2, pa3); MASKT(PX0, PX1, (t)); partialSM(PX0, PX1, m_reg, mnX, alX);                  \
        __syncthreads();                                                                                                      \
        if ((t) + 1 < NT) { VMW(); SWRITE_H(SB); }                                                                            \
        RESC(alX); __syncthreads(); } while (0)
    for (int t = 1; t + 1 < NT; t += 2) {
        HALF_STEP(pB0, pB1, mnB, alB, pA0, pA1, alA, t, 1, 0, 0);
        HALF_STEP(pA0, pA1, mnA, alA, pB0, pB1, alB, t + 1, 0, 1, 1);
    }
    const bool even = (NT & 1) == 0;
    if (even) { SBAR(); qkt<1>(pB0, pB1, K_lds, r32, hi, S.qr, KXf + KBASE(NT - 1)); SBAR(); }
    SLOAD_H(nxt.K, nxt.V, 0); SBAR();
#pragma unroll
    for (int d0 = 0; d0 < 8; ++d0) S.qr[d0] = load8(nxt.Q + (size_t)(wid * QBLK + r32) * LDQ + d0 * 16 + hi * 8);
    SBAR();
    finishSM(pA0, pA1, alA, l_reg, pa0, pa1, pa2, pa3); SBAR();
    pv_tile<0>(o, vb0, pa0, pa1, pa2, pa3);
    if (even) { MASKT(pB0, pB1, NT - 1); partialSM(pB0, pB1, m_reg, mnB, alB); __syncthreads(); RESC(alB);
        finishSM(pB0, pB1, alB, l_reg, pa0, pa1, pa2, pa3); SBAR(); pv_tile<1>(o, vb0, pa0, pa1, pa2, pa3); }
    SBAR(); SEAM_K0();
    if (hi == 0) li_l[r32] = l_reg; asm volatile("s_waitcnt lgkmcnt(0)" ::: "memory");
    int r32e = r32, hie = hi; asm volatile("" : "+v"(r32e), "+v"(hie));
    const int lane_off = 4 * hie * LDQ + r32e;
    bf16_t* Ow = cur.O + (size_t)(wid * QBLK) * LDQ;
    const int nv = cur.nvalid - wid * QBLK;
#pragma unroll
    for (int r = 0; r < 16; ++r) { const int orow = crow(r, hi); const float rli = __builtin_amdgcn_rcpf(li_l[orow]);
        if (orow < nv) {
#pragma unroll
            for (int d0 = 0; d0 < 4; ++d0) { bf16_t* gp = Ow + (lane_off + ((r & 3) + 8 * (r >> 2)) * LDQ + d0 * 32); const float v = o[d0][r] * rli * bf2f(*gp);
                const float vn = __shfl_xor(v, 1);
                if ((r32e & 1) == 0) *(unsigned*)gp = cvtpk(v, vn); } } }
    __syncthreads();
#undef RESC
#undef KBASE
#undef MASKT
#undef SEAM_K0
#undef HALF_STEP
}
#undef ROW
#undef VMW
#undef VMWN
#undef SLOAD_H
#undef SWRITE_HK
#undef SWRITE_HV
#undef SWRITE_H

__device__ __forceinline__ void build_kx(const Params& p, char* lds, int b, int h, bool sample, int P0, int nkeys) {
    int tid = threadIdx.x; asm volatile("" : "+v"(tid));
    const int wid = tid >> 6, lane = tid & 63;
    float* cs = (float*)(lds + OFF_CS);
    float v[4];
#pragma unroll
    for (int e = 0; e < 4; ++e) { const int key = tid * 4 + e; float x = 0.f;
        if (key < nkeys) { if (!sample) x = p.out[O_FLP + ((size_t)b * SEQ + key) * NH + h]; else x = (key < PAST) ? p.in[I_CFL][((size_t)b * PAST + key) * NH + h] : p.out[O_FLS + ((size_t)b * DECS + (key - PAST)) * NH + h]; }
        v[e] = x; }
    v[1] += v[0]; v[2] += v[1]; v[3] += v[2];
    float tot = v[3], inc = tot;
#pragma unroll
    for (int s = 1; s < 64; s <<= 1) { const float t = __shfl_up(inc, s); if (lane >= s) inc += t; }
    if (lane == 63) cs[wid] = inc;
    __syncthreads();
    float off = inc - tot;
    for (int w = 0; w < wid; ++w) off += cs[w];
#pragma unroll
    for (int e = 0; e < 4; ++e) { v[e] += off; if (tid * 4 + e == P0) cs[8] = v[e]; }
    __syncthreads();
    const float c0 = cs[8];
#pragma unroll
    for (int e = 0; e < 4; ++e) ((float*)(lds + OFF_KX))[tid * 4 + e] = (c0 - v[e]) * (1.0f / SCALE);
}
}

__device__ __forceinline__ att::BlockRef fox_ref(const Params& p, int bh, int qb) {
    unsigned char* ws = p.ws; unsigned char* ys = (unsigned char*)p.out; const int b = bh / NH, h = bh % NH; att::BlockRef r;
    if (qb < 8) { const size_t row0 = (size_t)b * SEQ; r.Q = (const bf16_t*)(ws + W_QB) + (row0 + qb * 256) * FW + h * 128; r.K = (const bf16_t*)(ws + W_KB) + row0 * FW + h * 128;
        r.V = (const bf16_t*)(ws + W_VB) + row0 * FW + h * 128; r.O = (bf16_t*)(ws + W_SGF) + (row0 + qb * 256) * FW + h * 128; r.P0 = qb * 256; r.skv = SEQ; r.nvalid = 256; }
    else { const size_t row0 = (size_t)MP + b * DECS; r.Q = (const bf16_t*)(ws + W_QB) + row0 * FW + h * 128; r.K = (const bf16_t*)(ys + Y_KS) + (size_t)b * SKVS * FW + h * 128;
        r.V = (const bf16_t*)(ys + Y_VS) + (size_t)b * SKVS * FW + h * 128; r.O = (bf16_t*)(ws + W_SGF) + row0 * FW + h * 128; r.P0 = PAST; r.skv = SKVS; r.nvalid = DECS; }
    return r;
}
__device__ __forceinline__ void phase_fox(const Params& p, char* lds) {
    static constexpr unsigned char BINS[8][8] = { {0x07, 0x06, 0, 0, 0, 0, 0, 0}, {0x17, 0x16, 0, 0, 0, 0, 0, 0}, {0x27, 0x26, 0, 0, 0, 0, 0, 0},
        {0x05, 0x04, 0x08, 0, 0, 0, 0, 0}, {0x15, 0x14, 0x18, 0, 0, 0, 0, 0}, {0x25, 0x24, 0x28, 0, 0, 0, 0, 0},
        {0x03, 0x13, 0x23, 0x02, 0, 0, 0, 0}, {0x12, 0x22, 0x01, 0x11, 0x21, 0x00, 0x10, 0x20} };
    static constexpr unsigned char BINN[8] = {2, 2, 2, 3, 3, 3, 4, 8};
    att::Seam S;
    for (int vb = blockIdx.x; vb < 256; vb += gridDim.x) {
        const int tri = vb >> 3, bin = vb & 7, n = BINN[bin];
        int it = BINS[bin][0]; att::BlockRef cur = fox_ref(p, tri * 3 + (it >> 4), it & 15);
        att::prime(cur, lds, S);
        for (int k = 0; k < n; ++k) {
            att::BlockRef nxt = cur; int itn = it;
            if (k + 1 < n) { itn = BINS[bin][k + 1]; nxt = fox_ref(p, tri * 3 + (itn >> 4), itn & 15); }
            const int bh = tri * 3 + (it >> 4);
            att::build_kx(p, lds, bh / NH, bh % NH, (it & 15) == 8, cur.P0, (it & 15) == 8 ? SKVS : cur.P0 + 256);
            __syncthreads();
            att::block(cur, nxt, lds, S);
            cur = nxt; it = itn;
        }
        asm volatile("s_waitcnt vmcnt(0)" ::: "memory");
        __syncthreads();
    }
}

struct SchedS {
    int G, c; const char* MQ; const char* MKB;
    __device__ __forceinline__ bool next(int i, Unit& u) const {
        const int L = i * G + c; if (L >= 288) return false;
        u.lda = MW; u.ldb = MW; u.nt = 4; u.kind = 0;
        if (L < 256) { const int pm = L >> 2, h = L & 3; u.pm = pm; u.pn = h; u.aux = -1; u.A = MQ + ((size_t)pm * 256 * MW + h * 256) * 2; u.B = MKB + ((size_t)(pm >> 3) * 256 * MW + h * 256) * 2; }
        else { const int idx = L - 256, b = idx >> 2, h = idx & 3; u.pm = 64 + (b >> 2); u.pn = h; u.aux = b & 3; u.A = MQ + ((size_t)u.pm * 256 * MW + h * 256) * 2; u.B = MKB + ((size_t)(2048 + b * 256) * MW + h * 256) * 2; }
        return true;
    }
};
struct EpiS {
    bf16_t* P;
    __device__ __forceinline__ void operator()(const f32x4 (&acc)[2][2][4][2], const Unit& u, int wr, int wc, int fr, int fq, LAS unsigned char* lds) const {
        typedef float f32x2v __attribute__((ext_vector_type(2)));
        LAS f32x2v* X = (LAS f32x2v*)(lds + LDS_X);
        constexpr float C2 = 1.4426950408889634f * 0.0625f;
        float mw[2][4];
#pragma unroll
        for (int ai = 0; ai < 2; ++ai)
#pragma unroll
            for (int m = 0; m < 4; ++m) { float mx = -3.0e38f;
#pragma unroll
                for (int bj = 0; bj < 2; ++bj)
#pragma unroll
                    for (int n = 0; n < 2; ++n) { const f32x4 x = acc[ai][bj][m][n]; mx = fmaxf(mx, fmaxf(fmaxf(x[0], x[1]), fmaxf(x[2], x[3]))); }
                mx = fmaxf(mx, __shfl_xor(mx, 16)); mx = fmaxf(mx, __shfl_xor(mx, 32));
                float s = 0.f;
#pragma unroll
                for (int bj = 0; bj < 2; ++bj)
#pragma unroll
                    for (int n = 0; n < 2; ++n) { const f32x4 x = acc[ai][bj][m][n];
#pragma unroll
                        for (int j = 0; j < 4; ++j) s += __builtin_amdgcn_exp2f((x[j] - mx) * C2); }
                s += __shfl_xor(s, 16); s += __shfl_xor(s, 32);
                mw[ai][m] = mx;
                if (fq == 0) X[(wr * 128 + ai * 64 + m * 16 + fr) * 4 + wc] = (f32x2v){mx, s}; }
        asm volatile("s_waitcnt lgkmcnt(0)" ::: "memory"); __builtin_amdgcn_s_barrier(); asm volatile("" ::: "memory");
        const int lo = (u.aux < 0) ? 0 : u.aux * 64, hiR = (u.aux < 0) ? 256 : lo + 64;
#pragma unroll
        for (int ai = 0; ai < 2; ++ai)
#pragma unroll
            for (int m = 0; m < 4; ++m) { const int rl = ai * 128 + wr * 64 + m * 16 + fr; const LAS f32x2v* xr = X + (wr * 128 + ai * 64 + m * 16 + fr) * 4;
                const f32x2v a = xr[0], b = xr[1], c = xr[2], d = xr[3];
                const float M = fmaxf(fmaxf(a.x, b.x), fmaxf(c.x, d.x));
                const float Lsum = a.y * __builtin_amdgcn_exp2f((a.x - M) * C2) + b.y * __builtin_amdgcn_exp2f((b.x - M) * C2) + c.y * __builtin_amdgcn_exp2f((c.x - M) * C2) + d.y * __builtin_amdgcn_exp2f((d.x - M) * C2);
                const float rl_ = __builtin_amdgcn_rcpf(Lsum);
                if (rl >= lo && rl < hiR) { bf16_t* rp = P + (size_t)(u.pm * 256 + rl) * MW + u.pn * 256 + wc * 32 + fq * 4;
#pragma unroll
                    for (int bj = 0; bj < 2; ++bj)
#pragma unroll
                        for (int n = 0; n < 2; ++n) { const f32x4 x = acc[ai][bj][m][n]; float e[4];
#pragma unroll
                            for (int j = 0; j < 4; ++j) e[j] = __builtin_amdgcn_exp2f((x[j] - M) * C2) * rl_;
                            *(u32x2*)(rp + bj * 128 + n * 16) = (u32x2){cvtpk(e[0], e[1]), cvtpk(e[2], e[3])}; } } }
        (void)mw;
    }
};

__device__ __forceinline__ void phase_conv(const Params& p) {
    unsigned char* ws = p.ws; const bf16_t* U = (const bf16_t*)(ws + W_U); bf16_t* BG = (bf16_t*)(ws + W_BGS);
    const float* cw = p.in[I_CW]; const float* cb = p.in[I_CB]; const float* st = p.in[I_SCONV];
    const size_t n = (size_t)MROWS * (FW / 8), g0 = (size_t)blockIdx.x * 512 + otid(), gs = (size_t)gridDim.x * 512;
    for (size_t i = g0; i < n; i += gs) { const int row = (int)(i / (FW / 8)), ch = (int)(i % (FW / 8)) * 8;
        float u0[8], u1[8], u2[8], g[8];
        unpack8(*(const u32x4*)(U + (size_t)row * FW + ch), u2); unpack8(*(const u32x4*)(BG + (size_t)row * FW + ch), g);
        int t; const float* s0 = nullptr;
        if (row < MP) t = row & (SEQ - 1); else { const int rs = row - MP; t = rs & 63; s0 = st + (size_t)(rs >> 6) * 2 * FW + ch; }
        if (t >= 1) unpack8(*(const u32x4*)(U + (size_t)(row - 1) * FW + ch), u1);
        else {
#pragma unroll
            for (int e = 0; e < 8; ++e) u1[e] = s0 ? s0[FW + e] : 0.f; }
        if (t >= 2) unpack8(*(const u32x4*)(U + (size_t)(row - 2) * FW + ch), u0);
        else {
#pragma unroll
            for (int e = 0; e < 8; ++e) u0[e] = s0 ? s0[(size_t)t * FW + e] : 0.f; }
        float o[8];
#pragma unroll
        for (int e = 0; e < 8; ++e) o[e] = g[e] * (cw[ch + e] * u0[e] + cw[FW + ch + e] * u1[e] + cw[2 * FW + ch + e] * u2[e] + cb[ch + e]);
        *(u32x4*)(BG + (size_t)row * FW + ch) = (u32x4){cvtpk(o[0], o[1]), cvtpk(o[2], o[3]), cvtpk(o[4], o[5]), cvtpk(o[6], o[7])}; }
}

struct SchedPV {
    int G, c; const char* P; const char* VT;
    __device__ __forceinline__ bool next(int i, Unit& u) const {
        const int L = i * G + c; if (L >= 288) return false;
        u.lda = MW; u.ldb = 256; u.nt = 4; u.kind = 0;
        if (L < 256) { const int pm = L >> 2, h = L & 3; u.pm = pm; u.pn = h; u.aux = -1; u.A = P + ((size_t)pm * 256 * MW + h * 256) * 2; u.B = VT + ((size_t)(pm >> 3) * MW + h * 256) * 256 * 2; }
        else { const int idx = L - 256, b = idx >> 2, h = idx & 3; u.pm = 64 + (b >> 2); u.pn = h; u.aux = b & 3; u.A = P + ((size_t)u.pm * 256 * MW + h * 256) * 2; u.B = VT + ((size_t)(8 + b) * MW + h * 256) * 256 * 2; }
        return true;
    }
};
struct EpiPV {
    bf16_t* SGM;
    __device__ __forceinline__ void operator()(const f32x4 (&acc)[2][2][4][2], const Unit& u, int wr, int wc, int fr, int fq, LAS unsigned char*) const {
        const int lo = (u.aux < 0) ? 0 : u.aux * 64, hiR = (u.aux < 0) ? 256 : lo + 64;
#pragma unroll
        for (int ai = 0; ai < 2; ++ai)
#pragma unroll
            for (int m = 0; m < 4; ++m) { const int rl = ai * 128 + wr * 64 + m * 16 + fr;
                if (rl >= lo && rl < hiR) { bf16_t* rp = SGM + (size_t)(u.pm * 256 + rl) * MW + u.pn * 256 + wc * 32 + fq * 8;
#pragma unroll
                    for (int bj = 0; bj < 2; ++bj) { float g[8]; unpack8(*(const u32x4*)(rp + bj * 128), g); const f32x4 a = acc[ai][bj][m][0], b = acc[ai][bj][m][1];
                        *(u32x4*)(rp + bj * 128) = (u32x4){cvtpk(a[0] * g[0], a[1] * g[1]), cvtpk(a[2] * g[2], a[3] * g[3]), cvtpk(b[0] * g[4], b[1] * g[5]), cvtpk(b[2] * g[6], b[3] * g[7])}; } } }
    }
};
__device__ __forceinline__ void phase_prep2(const Params& p, char* smem) {
    float* tile = (float*)smem; unsigned char* ws = p.ws; const int G = gridDim.x, c = blockIdx.x; int ctr = 0;
    bf16_t* WTC = (bf16_t*)(ws + W_WTC);
    tr_matrix<0>(p.in[I_WMG], 6144, (bf16_t*)(ws + W_WTM), DM, 6144, DM, tile, ctr, G, c);
    tr_matrix<0>(p.in[I_WFO], DM, WTC, 4096, DM, FW, tile, ctr, G, c);
    tr_matrix<0>(p.in[I_WCO], DM, WTC + FW, 4096, DM, FW, tile, ctr, G, c);
    tr_matrix<0>(p.in[I_WMO], DM, WTC + 2 * FW, 4096, DM, MW, tile, ctr, G, c);
    tr_matrix<0>(p.in[I_WO], DM, (bf16_t*)(ws + W_WTO), DM, DM, DM, tile, ctr, G, c);
}

struct SchedE1 {
    int G, c; const char* XB; const char* WTM; const char* WTC; const char* AF; const char* AC; const char* AM;
    __device__ __forceinline__ bool next(int i, Unit& u) const {
        const int tr = i / 6, s = i - tr * 6;
        int pm, pn;
        if (G == 256) { pm = 4 * ((c & 7) + 8 * tr) + ((c >> 3) & 3); pn = c >> 5; if (pm >= NPAN) return false; }
        else { const int T = tr * G + c; if (T >= NPAN * 8) return false; pn = T / NPAN; pm = T % NPAN; }
        const int br = s >> 1; u.pm = pm; u.pn = pn; u.kind = s; u.aux = br;
        if ((s & 1) == 0) { u.A = XB + (size_t)pm * 256 * DM * 2; u.B = WTM + ((size_t)br * DM + pn * 256) * DM * 2; u.lda = DM; u.ldb = DM; u.nt = DM / BK; }
        else { u.ldb = 4096; u.B = WTC + ((size_t)pn * 256 * 4096 + (br == 0 ? 0 : (br == 1 ? FW : 2 * FW))) * 2;
            if (br == 0) { u.A = AF + (size_t)pm * 256 * FW * 2; u.lda = FW; u.nt = FW / BK; } else if (br == 1) { u.A = AC + (size_t)pm * 256 * FW * 2; u.lda = FW; u.nt = FW / BK; }
            else { u.A = AM + (size_t)pm * 256 * MW * 2; u.lda = MW; u.nt = MW / BK; } }
        return true;
    }
};
struct EpiE1 {
    unsigned char* gs; unsigned char* msc; bf16_t* MB; const float* bmg;
    __device__ __forceinline__ void operator()(const f32x4 (&acc)[2][2][4][2], const Unit& u, int wr, int wc, int fr, int fq, LAS unsigned char*) const {
        int tid = threadIdx.x; asm volatile("" : "+v"(tid));
        const int s = u.kind, cl = wc * 32 + fq * 8;
        unsigned char* gsl = gs + (size_t)tid * 16; unsigned char* mscl = msc + (size_t)tid * 16;
        if ((s & 1) == 0) {
            const float* bp = bmg + u.aux * DM + u.pn * 256 + cl; f32x4 bv[2][2];
#pragma unroll
            for (int bj = 0; bj < 2; ++bj)
#pragma unroll
                for (int n = 0; n < 2; ++n) bv[bj][n] = *(const f32x4*)(bp + bj * 128 + n * 4);
#pragma unroll
            for (int ai = 0; ai < 2; ++ai)
#pragma unroll
                for (int bj = 0; bj < 2; ++bj)
#pragma unroll
                    for (int m = 0; m < 4; ++m) { f32x4 a = acc[ai][bj][m][0] + bv[bj][0], b = acc[ai][bj][m][1] + bv[bj][1];
#pragma unroll
                        for (int j = 0; j < 4; ++j) { a[j] = sigmoidf_(a[j]); b[j] = sigmoidf_(b[j]); }
                        *(u32x4*)(gsl + (((ai * 2 + bj) * 4 + m) * 8192)) = pack8u(a, b); asm volatile("" ::: "memory"); }
        } else {
#pragma unroll
            for (int ai = 0; ai < 2; ++ai)
#pragma unroll
                for (int bj = 0; bj < 2; ++bj)
#pragma unroll
                    for (int m = 0; m < 4; ++m) { const int k = (ai * 2 + bj) * 4 + m; float g[8]; unpack8(*(const u32x4*)(gsl + k * 8192), g);
                        f32x4 a = acc[ai][bj][m][0], b = acc[ai][bj][m][1];
#pragma unroll
                        for (int j = 0; j < 4; ++j) { a[j] *= g[j]; b[j] *= g[4 + j]; }
                        f32x4* mp = (f32x4*)(mscl + (k * 2) * 8192); f32x4* mq = (f32x4*)(mscl + (k * 2 + 1) * 8192);
                        if (s == 1) { *mp = a; *mq = b; }
                        else if (s == 3) { *mp = *mp + a; *mq = *mq + b; }
                        else { a = a + *mp; b = b + *mq; *(u32x4*)(MB + (size_t)(u.pm * 256 + ai * 128 + wr * 64 + m * 16 + fr) * DM + u.pn * 256 + bj * 128 + cl) = pack8u(a, b); }
                        if (m & 1) asm volatile("" ::: "memory"); }
        }
    }
};

struct SchedE2 {
    int G, c; const char* MB; const char* WTO;
    __device__ __forceinline__ bool next(int i, Unit& u) const {
        int pm, pn;
        if (G == 256) { pm = 4 * ((c & 7) + 8 * i) + ((c >> 3) & 3); pn = c >> 5; if (pm >= NPAN) return false; }
        else { const int T = i * G + c; if (T >= NPAN * 8) return false; pn = T / NPAN; pm = T % NPAN; } u.pm = pm; u.pn = pn; u.kind = 0; u.aux = 0; u.lda = DM; u.ldb = DM; u.nt = DM / BK;
        u.A = MB + (size_t)pm * 256 * DM * 2; u.B = WTO + (size_t)pn * 256 * DM * 2; return true;
    }
};
struct EpiE2 {
    float* out; const float* xp; const float* xs;
    __device__ __forceinline__ void operator()(const f32x4 (&acc)[2][2][4][2], const Unit& u, int wr, int wc, int fr, int fq, LAS unsigned char*) const {
        constexpr float ALPHA = 1.189207115002721f;
        const int cl = u.pn * 256 + wc * 32 + fq * 8;
#pragma unroll
        for (int ai = 0; ai < 2; ++ai)
#pragma unroll
            for (int m = 0; m < 4; ++m) { const int row = u.pm * 256 + ai * 128 + wr * 64 + m * 16 + fr; const float* xr; float* yr;
                if (row < MP) { xr = xp + (size_t)row * DM; yr = out + O_YP + (size_t)row * DM; } else { xr = xs + (size_t)(row - MP) * DM; yr = out + O_YS + (size_t)(row - MP) * DM; }
#pragma unroll
                for (int bj = 0; bj < 2; ++bj) { const int col = cl + bj * 128; const f32x4 x0 = *(const f32x4*)(xr + col), x1 = *(const f32x4*)(xr + col + 4);
                    *(f32x4*)(yr + col) = x0 * ALPHA + acc[ai][bj][m][0]; *(f32x4*)(yr + col + 4) = x1 * ALPHA + acc[ai][bj][m][1]; } }
    }
};

__device__ __forceinline__ void phase_ln(const Params& p) {
    const int tid = otid(), wid = tid >> 6, lane = tid & 63; const float* g = p.in[I_LNG]; const float* bb = p.in[I_LNB];
    for (int row = blockIdx.x * 8 + wid; row < MROWS; row += gridDim.x * 8) {
        float* yr = p.out + (row < MP ? O_YP + (size_t)row * DM : O_YS + (size_t)(row - MP) * DM);
        f32x4 v[8]; float s = 0.f;
#pragma unroll
        for (int i = 0; i < 8; ++i) { v[i] = *(const f32x4*)(yr + i * 256 + lane * 4); s += (v[i][0] + v[i][1]) + (v[i][2] + v[i][3]); }
#pragma unroll
        for (int o = 32; o >= 1; o >>= 1) s += __shfl_xor(s, o);
        const float mu = s * (1.0f / DM); float q = 0.f;
#pragma unroll
        for (int i = 0; i < 8; ++i) { const f32x4 d = v[i] - mu; q += (d[0] * d[0] + d[1] * d[1]) + (d[2] * d[2] + d[3] * d[3]); }
#pragma unroll
        for (int o = 32; o >= 1; o >>= 1) q += __shfl_xor(q, o);
        const float rstd = 1.0f / sqrtf(q * (1.0f / DM) + 1e-5f);
#pragma unroll
        for (int i = 0; i < 8; ++i) { const int col = i * 256 + lane * 4; const f32x4 gg = *(const f32x4*)(g + col), b4 = *(const f32x4*)(bb + col);
            *(f32x4*)(yr + col) = (v[i] - mu) * rstd * gg + b4; }
    }
}

#define GSYNC() do { __threadfence(); grid.sync(); __builtin_amdgcn_fence(__ATOMIC_ACQUIRE, "agent"); asm volatile("s_waitcnt vmcnt(0)" ::: "memory"); __syncthreads(); } while (0)
__global__ void __launch_bounds__(512) fwd_megakernel(Params p) {
    extern __shared__ __attribute__((aligned(16))) unsigned char smem[];
    cg::grid_group grid = cg::this_grid();
    LAS unsigned char* lds = (LAS unsigned char*)smem;
    unsigned char* ws = p.ws; unsigned char* ys = (unsigned char*)p.out;
    const int G = gridDim.x, c = blockIdx.x;

#ifndef PH
#define PH 0xFFFF
#endif
#if PH & 1
    phase_prep(p, (char*)smem);
#endif
    GSYNC();
#if PH & 2
    { SchedB S{G, c, (const char*)(ws + W_XB), (const char*)(ws + W_WTA)}; EpiB E{p.out, ws, p.in[I_FBF]}; gemm_phase(lds, S, E); }
#endif
    GSYNC();
#if PH & 4
    phase_fox(p, (char*)smem);
#endif
    __syncthreads();
#if PH & 8
    { SchedS S{G, c, (const char*)(ys + Y_MQ), (const char*)(ys + Y_MKB)}; EpiS E{(bf16_t*)(ws + W_P)}; gemm_phase(lds, S, E); }
#endif
#if PH & 16
    phase_conv(p);
#endif
    GSYNC();
#if PH & 32
    { SchedPV S{G, c, (const char*)(ws + W_P), (const char*)(ws + W_VT)}; EpiPV E{(bf16_t*)(ys + Y_SGM)}; gemm_phase(lds, S, E); }
#endif
    __syncthreads();
#if PH & 64
    phase_prep2(p, (char*)smem);
#endif
    GSYNC();
#if PH & 128
    { SchedE1 S{G, c, (const char*)(ws + W_XB), (const char*)(ws + W_WTM), (const char*)(ws + W_WTC), (const char*)(ws + W_SGF), (const char*)(ws + W_BGS), (const char*)(ys + Y_SGM)};
      EpiE1 E{ws + W_GS + (size_t)c * 131072, ws + W_MSC + (size_t)c * 262144, (bf16_t*)(ws + W_MB), p.in[I_BMG]}; gemm_phase(lds, S, E); }
#endif
    GSYNC();
#if PH & 256
    { SchedE2 S{G, c, (const char*)(ws + W_MB), (const char*)(ws + W_WTO)}; EpiE2 E{p.out, p.in[I_XP], p.in[I_XS]}; gemm_phase(lds, S, E); }
#endif
    GSYNC();
#if PH & 512
    phase_ln(p);
#endif
}

extern "C" void kernel_launch(void* const* d_in, const int* in_sizes, int n_in, void* d_out, int out_size, void* d_ws, size_t ws_size, hipStream_t stream) {
    static int grid_blocks = 0;
    if (grid_blocks == 0) {
        if (n_in != 22 || (size_t)out_size != O_END || ws_size < W_END) { fprintf(stderr, "kernel_launch: unexpected shapes (n_in %d, out %d, ws %zu, need %zu)\n", n_in, out_size, ws_size, (size_t)W_END); grid_blocks = -1; return; }
        int dev = 0, cus = 0, per_cu = 0;
        (void)hipGetDevice(&dev); (void)hipDeviceGetAttribute(&cus, hipDeviceAttributeMultiprocessorCount, dev);
        if (hipFuncSetAttribute((const void*)fwd_megakernel, hipFuncAttributeMaxDynamicSharedMemorySize, LDS_BYTES) != hipSuccess) { fprintf(stderr, "kernel_launch: hipFuncSetAttribute failed\n"); grid_blocks = -1; return; }
        if (hipOccupancyMaxActiveBlocksPerMultiprocessor(&per_cu, (const void*)fwd_megakernel, 512, LDS_BYTES) != hipSuccess || per_cu < 1) { fprintf(stderr, "kernel_launch: occupancy query says %d\n", per_cu); grid_blocks = -1; return; }
        int g = cus * per_cu; if (g > 256) g = 256; g &= ~7; if (g < 8) g = 8;
        grid_blocks = g;
    }
    if (grid_blocks < 0) return;
    Params p{};
    for (int i = 0; i < 22; ++i) p.in[i] = (const float*)d_in[i];
    p.out = (float*)d_out; p.ws = (unsigned char*)d_ws;
    void* args[] = {&p};
    hipError_t e = hipLaunchCooperativeKernel((const void*)fwd_megakernel, dim3(grid_blocks), dim3(512), args, LDS_BYTES, stream);
    if (e != hipSuccess) fprintf(stderr, "kernel_launch: cooperative launch failed: %s (grid %d)\n", hipGetErrorString(e), grid_blocks);
}
```

```cpp
#include <hip/hip_runtime.h>
#include <hip/hip_cooperative_groups.h>
#include <cstdio>
#include <cstdint>
namespace cg = cooperative_groups;

#define LAS __attribute__((address_space(3)))
typedef unsigned short bf16_t;
typedef short bf16x8 __attribute__((ext_vector_type(8)));
typedef short s16x4 __attribute__((ext_vector_type(4)));
typedef float f32x4 __attribute__((ext_vector_type(4)));
typedef float f32x16 __attribute__((ext_vector_type(16)));
typedef unsigned u32x4 __attribute__((ext_vector_type(4)));
typedef unsigned u32x2 __attribute__((ext_vector_type(2)));

constexpr int DM = 2048, MP = 16384, MS = 512, MM = 2048, SEQ = 2048, DECS = 64, PAST = 1024, NBATCH = 8;
constexpr int FW = 1536, MW = 1024, INW = 14348, NH = 12, SKVS = PAST + DECS;
constexpr int MROWS = MP + MS;
constexpr int NPAN = MROWS / 256;
constexpr int NTA = 57;
constexpr size_t O_YP = 0, O_YS = O_YP + (size_t)MP * DM, O_FKP = O_YS + (size_t)MS * DM, O_FVP = O_FKP + (size_t)MP * FW,
                 O_FLP = O_FVP + (size_t)MP * FW, O_CVP = O_FLP + (size_t)MP * NH, O_MKP = O_CVP + (size_t)NBATCH * 2 * FW,
                 O_MVP = O_MKP + (size_t)MM * MW, O_FKS = O_MVP + (size_t)MM * MW, O_FVS = O_FKS + (size_t)MS * FW,
                 O_FLS = O_FVS + (size_t)MS * FW, O_CVS = O_FLS + (size_t)MS * NH, O_END = O_CVS + (size_t)NBATCH * 2 * FW;
constexpr size_t Y_KS = 0, Y_VS = Y_KS + (size_t)NBATCH * SKVS * FW * 2, Y_MQ = Y_VS + (size_t)NBATCH * SKVS * FW * 2,
                 Y_SGM = Y_MQ + (size_t)MROWS * MW * 2, Y_MKB = Y_SGM + (size_t)MROWS * MW * 2, Y_END = Y_MKB + (size_t)4096 * MW * 2;
static_assert(Y_END <= (size_t)MP * DM * 4, "y scratch");
constexpr size_t W_XB = 0, W_WTA = W_XB + (size_t)(MROWS + MM) * DM * 2, W_QB = W_WTA + (size_t)16640 * DM * 2,
                 W_KB = W_QB + (size_t)(MROWS + 256) * FW * 2, W_VB = W_KB + (size_t)MP * FW * 2, W_U = W_VB + (size_t)MP * FW * 2,
                 W_SGF = W_U + (size_t)MROWS * FW * 2, W_BGS = W_SGF + (size_t)MROWS * FW * 2, W_VT = W_BGS + (size_t)MROWS * FW * 2,
                 W_END = W_VT + (size_t)16 * MW * 256 * 2;
constexpr size_t W_P = W_WTA, W_WTC = W_P + (size_t)MROWS * MW * 2, W_WTO = W_WTC + (size_t)DM * 4096 * 2, W_A1END = W_WTO + (size_t)DM * DM * 2;
static_assert(W_A1END <= W_QB, "alias 1");
constexpr size_t W_GS = W_QB, W_MSC = W_GS + (size_t)256 * 131072, W_MB = W_MSC + (size_t)256 * 262144, W_WTM = W_MB + (size_t)MROWS * DM * 2,
                 W_A2END = W_WTM + (size_t)6144 * DM * 2;
static_assert(W_A2END <= W_SGF, "alias 2");
static_assert(W_END <= (size_t)536870912, "workspace");

constexpr int LDS_STAGE = 131072, LDS_X = LDS_STAGE, LDS_BYTES = LDS_STAGE + 8192;

struct Params { const float* in[22]; float* out; unsigned char* ws; };
enum { I_XP = 0, I_XS, I_MEM, I_CFK, I_CFV, I_CFL, I_SCONV, I_CMK, I_CMV, I_WIN, I_FBF, I_CW, I_CB, I_WMKV, I_WFO, I_WCO, I_WMO, I_WMG, I_BMG, I_WO, I_LNG, I_LNB };

typedef __bf16 bf16x2_t __attribute__((ext_vector_type(2)));
typedef float f32x2_t __attribute__((ext_vector_type(2)));
__device__ __forceinline__ unsigned cvtpk(float lo, float hi) { const f32x2_t f = {lo, hi}; const bf16x2_t r = __builtin_convertvector(f, bf16x2_t); return __builtin_bit_cast(unsigned, r); }
__device__ __forceinline__ float bflo(unsigned w) { return __uint_as_float(w << 16); }
__device__ __forceinline__ float bfhi(unsigned w) { return __uint_as_float(w & 0xffff0000u); }
__device__ __forceinline__ float bf2f(bf16_t b) { return __uint_as_float(((unsigned)b) << 16); }
__device__ __forceinline__ u32x4 pack8u(f32x4 a, f32x4 b) { u32x4 w = {cvtpk(a[0], a[1]), cvtpk(a[2], a[3]), cvtpk(b[0], b[1]), cvtpk(b[2], b[3])}; return w; }
__device__ __forceinline__ bf16x8 pack8(f32x4 a, f32x4 b) { u32x4 w = pack8u(a, b); return *reinterpret_cast<bf16x8*>(&w); }
__device__ __forceinline__ float sigmoidf_(float x) { return __builtin_amdgcn_rcpf(1.f + __expf(-x)); }
__device__ __forceinline__ float siluf_(float x) { return x * sigmoidf_(x); }
__device__ __forceinline__ void unpack8(u32x4 w, float (&f)[8]) { f[0] = bflo(w.x); f[1] = bfhi(w.x); f[2] = bflo(w.y); f[3] = bfhi(w.y); f[4] = bflo(w.z); f[5] = bfhi(w.z); f[6] = bflo(w.w); f[7] = bfhi(w.w); }
__device__ __forceinline__ int otid() { int t = threadIdx.x; asm volatile("" : "+v"(t)); return t; }
__host__ __device__ __forceinline__ int perm32(int rho) { const int n = rho >> 4, i = rho & 15; return 8 * (i >> 2) + 4 * n + (i & 3); }
__host__ __device__ __forceinline__ int perm32inv(int l) { return 16 * ((l >> 2) & 1) + 4 * (l >> 3) + (l & 3); }

constexpr int BK = 64, HTB = 128 * BK * 2;
__device__ __forceinline__ int lds_byte(int r, int c) { const int st = (r >> 4) * 2 + (c >> 5), rr = r & 15, cc = c & 31, ob = rr * 64 + cc * 2; return st * 1024 + (ob ^ (((ob >> 9) & 1) << 5)); }
__device__ __forceinline__ void stage_rc(int b, int& R, int& C) { const int st = b / 1024, sb = b % 1024, swz = sb ^ (((sb >> 9) & 1) << 5); R = (st >> 1) * 16 + swz / 64; C = (st & 1) * 32 + (swz % 64) / 2; }

struct Unit { const char* A; const char* B; int lda, ldb, nt, kind, pm, pn, aux; };

template <class Sched, class Epi>
__device__ __forceinline__ void gemm_phase(LAS unsigned char* lds, const Sched& S, const Epi& E) {
    const int tid = otid(), wid = __builtin_amdgcn_readfirstlane(tid >> 6), lane = tid & 63, wr = wid >> 2, wc = wid & 3, fr = lane & 15, fq = lane >> 4;
    int sR0, sC0; stage_rc(tid * 16, sR0, sC0); const int sC2 = sC0 * 2;
    const size_t kstep = (size_t)(BK * 2);
    const unsigned ldsw = (unsigned)wid * 1024u;
    const int aoff = lds_byte(wr * 64 + fr, fq * 8), boff = lds_byte(wc * 32 + fr, fq * 8);
#define G_SA(b, h) (((b) * 2 + (h)) * HTB)
#define G_SB(b, h) ((4 + (b) * 2 + (h)) * HTB)
#define G_STAGE(bufoff, gbase, ld2) do { const unsigned v_ = (unsigned)sR0 * (unsigned)(ld2) + (unsigned)sC2; \
        __builtin_amdgcn_global_load_lds((const unsigned*)((const char*)(gbase) + v_), (LAS unsigned*)(lds + (bufoff) + ldsw), 16, 0, 0); \
        __builtin_amdgcn_global_load_lds((const unsigned*)((const char*)(gbase) + (size_t)(64u * (unsigned)(ld2)) + v_), (LAS unsigned*)(lds + (bufoff) + ldsw + 8192), 16, 0, 0); } while (0)
#define G_LDA(dst, b, h) do { _Pragma("unroll") for (int m = 0; m < 4; ++m) _Pragma("unroll") for (int k = 0; k < 2; ++k) dst[m][k] = *(const LAS bf16x8*)(lds + G_SA(b, h) + aoff + m * 2048 + k * 1024); } while (0)
#define G_LDB(dst, b, h) do { _Pragma("unroll") for (int n = 0; n < 2; ++n) _Pragma("unroll") for (int k = 0; k < 2; ++k) dst[n][k] = *(const LAS bf16x8*)(lds + G_SB(b, h) + boff + n * 2048 + k * 1024); } while (0)
#define G_MMA(ai, bj, At, Bt) do { __builtin_amdgcn_s_setprio(1); _Pragma("unroll") for (int m = 0; m < 4; ++m) _Pragma("unroll") for (int n = 0; n < 2; ++n) _Pragma("unroll") for (int k = 0; k < 2; ++k) \
        acc[ai][bj][m][n] = __builtin_amdgcn_mfma_f32_16x16x32_bf16(Bt[n][k], At[m][k], acc[ai][bj][m][n], 0, 0, 0); __builtin_amdgcn_s_setprio(0); } while (0)
#define G_WAIT_V(n) asm volatile("s_waitcnt vmcnt(" #n ")" ::: "memory")
#define G_WAIT_L(n) asm volatile("s_waitcnt lgkmcnt(" #n ")" ::: "memory")
#define G_BAR __builtin_amdgcn_s_barrier()
#define G_SCHED __builtin_amdgcn_sched_barrier(0)
    Unit cur, nxt; int ui = 0;
    if (!S.next(0, cur)) return;
    f32x4 acc[2][2][4][2];
#pragma unroll
    for (int a = 0; a < 2; ++a)
#pragma unroll
        for (int b = 0; b < 2; ++b)
#pragma unroll
            for (int m = 0; m < 4; ++m)
#pragma unroll
                for (int n = 0; n < 2; ++n) acc[a][b][m][n] = (f32x4){0.f, 0.f, 0.f, 0.f};
    bf16x8 At[4][2], B0[2][2], B1[2][2];
    const char* cA = cur.A; const char* cB = cur.B;
    int lA2 = cur.lda * 2, lB2 = cur.ldb * 2;
    size_t hA = (size_t)128 * lA2, hB = (size_t)128 * lB2;
    G_STAGE(G_SB(0, 0), cB, lB2); G_STAGE(G_SA(0, 0), cA, lA2); G_STAGE(G_SB(0, 1), cB + hB, lB2); G_STAGE(G_SA(0, 1), cA + hA, lA2);
    if (wr == 1) G_BAR;
    G_WAIT_V(4); G_BAR;
    G_STAGE(G_SB(1, 0), cB + kstep, lB2); G_STAGE(G_SA(1, 0), cA + kstep, lA2); G_STAGE(G_SB(1, 1), cB + hB + kstep, lB2);
    G_WAIT_V(6); G_BAR;
    for (;;) {
        const bool has_next = S.next(ui + 1, nxt);
        if (!has_next) nxt = cur;
        const char* nA = nxt.A; const char* nB = nxt.B;
        const int nlA2 = nxt.lda * 2, nlB2 = nxt.ldb * 2;
        const size_t nhA = (size_t)128 * nlA2, nhB = (size_t)128 * nlB2;
        const int nt = cur.nt;
        for (int t = 0; t < nt; t += 2) {
            const bool last = (t == nt - 2);
            const char* a1 = cA + (size_t)(t + 1) * kstep;
            const char* a2 = last ? nA : cA + (size_t)(t + 2) * kstep; const char* b2 = last ? nB : cB + (size_t)(t + 2) * kstep;
            const char* a3 = a2 + kstep; const char* b3 = b2 + kstep;
            const int xlA2 = last ? nlA2 : lA2, xlB2 = last ? nlB2 : lB2;
            const size_t xhA = last ? nhA : hA, xhB = last ? nhB : hB;
            G_LDB(B0, 0, 0); G_SCHED; G_LDA(At, 0, 0); G_STAGE(G_SA(1, 1), a1 + hA, lA2);
            G_WAIT_L(8); G_BAR; G_WAIT_L(0); G_MMA(0, 0, At, B0); G_BAR; G_SCHED;
            G_LDB(B1, 0, 1); G_STAGE(G_SB(0, 0), b2, xlB2);
            G_BAR; G_WAIT_L(0); G_MMA(0, 1, At, B1); G_BAR;
            G_LDA(At, 0, 1); G_STAGE(G_SA(0, 0), a2, xlA2);
            G_BAR; G_WAIT_L(0); G_MMA(1, 0, At, B0); G_BAR; G_SCHED;
            G_STAGE(G_SB(0, 1), b2 + xhB, xlB2);
            G_WAIT_V(6); G_BAR; G_MMA(1, 1, At, B1); G_BAR;
            G_LDB(B0, 1, 0); G_SCHED; G_LDA(At, 1, 0); G_STAGE(G_SA(0, 1), a2 + xhA, xlA2);
            G_WAIT_L(8); G_BAR; G_WAIT_L(0); G_MMA(0, 0, At, B0); G_BAR; G_SCHED;
            G_LDB(B1, 1, 1); G_STAGE(G_SB(1, 0), b3, xlB2);
            G_BAR; G_WAIT_L(0); G_MMA(0, 1, At, B1); G_BAR;
            G_LDA(At, 1, 1); G_STAGE(G_SA(1, 0), a3, xlA2);
            G_BAR; G_WAIT_L(0); G_MMA(1, 0, At, B0); G_BAR; G_SCHED;
            G_STAGE(G_SB(1, 1), b3 + xhB, xlB2);
            G_WAIT_V(6); G_BAR; G_MMA(1, 1, At, B1); G_BAR;
        }
        E(acc, cur, wr, wc, fr, fq, lds);
        if (!has_next) break;
#pragma unroll
        for (int a = 0; a < 2; ++a)
#pragma unroll
            for (int b = 0; b < 2; ++b)
#pragma unroll
                for (int m = 0; m < 4; ++m)
#pragma unroll
                    for (int n = 0; n < 2; ++n) acc[a][b][m][n] = (f32x4){0.f, 0.f, 0.f, 0.f};
        cur = nxt; cA = nA; cB = nB; lA2 = nlA2; lB2 = nlB2; hA = nhA; hB = nhB; ++ui;
    }
    G_WAIT_V(0);
    if (wr == 0) G_BAR;
    G_BAR;
#undef G_STAGE
#undef G_LDA
#undef G_LDB
#undef G_MMA
}

__device__ __forceinline__ void conv_rows(const float* src, bf16_t* dst, size_t n8, size_t g0, size_t gs) {
    size_t i = g0;
    for (; i + 3 * gs < n8; i += 4 * gs) { f32x4 a[4], b[4];
#pragma unroll
        for (int u = 0; u < 4; ++u) { a[u] = *(const f32x4*)(src + (i + u * gs) * 8); b[u] = *(const f32x4*)(src + (i + u * gs) * 8 + 4); }
#pragma unroll
        for (int u = 0; u < 4; ++u) *(u32x4*)(dst + (i + u * gs) * 8) = pack8u(a[u], b[u]); }
    for (; i < n8; i += gs) { const f32x4 a = *(const f32x4*)(src + i * 8), b = *(const f32x4*)(src + i * 8 + 4); *(u32x4*)(dst + i * 8) = pack8u(a, b); }
}
__device__ __forceinline__ int colmapA(int lc) {
    const int t = lc >> 8, o = lc & 255;
    if (t < 18) return lc;
    if (t < 24) return 4620 + (lc - 4608);
    if (t < 36) { const int i = t - 24; return (o < 128) ? 7692 + 128 * i + o : 9228 + 128 * i + (o - 128); }
    if (t < 48) { const int i = t - 36; return (o < 128) ? 6156 + 128 * i + o : 10764 + 128 * i + (o - 128); }
    if (t < 52) return 12300 + (lc - 48 * 256);
    if (t < 56) return 13324 + (lc - 52 * 256);
    return (o < 12) ? 4608 + o : -1;
}
constexpr int TRS = 132;
template <int MODE>
__device__ __forceinline__ void tr_tile(const float* src, int sld, bf16_t* dst, int dld, int j0, int k0, float* tile) {
    const int tid = otid();
    { const int jq = tid & 31, kk0 = tid >> 5; const int j = j0 + jq * 4; int col;
      if (MODE == 2) col = j; else { const int lc = (j & ~31) + perm32(j & 31); col = (MODE == 1) ? colmapA(lc) : lc; }
      f32x4 v[8];
#pragma unroll
      for (int i = 0; i < 8; ++i) { const int kk = kk0 + 16 * i; v[i] = (col >= 0) ? *(const f32x4*)(src + (size_t)(k0 + kk) * sld + col) : (f32x4){0.f, 0.f, 0.f, 0.f}; }
#pragma unroll
      for (int i = 0; i < 8; ++i) *(f32x4*)(tile + (kk0 + 16 * i) * TRS + jq * 4) = v[i]; }
    __syncthreads();
    { const int jj = tid & 127, kc = tid >> 7; bf16_t* dp = dst + (size_t)(j0 + jj) * dld + k0 + kc * 32;
#pragma unroll
      for (int q = 0; q < 4; ++q) { float v[8];
#pragma unroll
          for (int e = 0; e < 8; ++e) v[e] = tile[(kc * 32 + q * 8 + e) * TRS + jj];
          *(u32x4*)(dp + q * 8) = (u32x4){cvtpk(v[0], v[1]), cvtpk(v[2], v[3]), cvtpk(v[4], v[5]), cvtpk(v[6], v[7])}; } }
    __syncthreads();
}
template <int MODE>
__device__ __forceinline__ void tr_matrix(const float* src, int sld, bf16_t* dst, int dld, int nj, int nk, float* tile, int& ctr, int G, int c) {
    const int tk = nk / 128, total = (nj / 128) * tk;
    int t0 = (c - ctr % G) % G; if (t0 < 0) t0 += G;
    for (int t = t0; t < total; t += G) tr_tile<MODE>(src, sld, dst, dld, (t / tk) * 128, (t % tk) * 128, tile);
    ctr += total;
}

__device__ __forceinline__ void phase_prep(const Params& p, char* smem) {
    float* tile = (float*)smem;
    unsigned char* ws = p.ws; unsigned char* ys = (unsigned char*)p.out;
    const int G = gridDim.x, c = blockIdx.x; const size_t g0 = (size_t)c * 512 + otid(), gs = (size_t)G * 512;
    bf16_t* XB = (bf16_t*)(ws + W_XB);
    int ctr = 0;
    tr_matrix<1>(p.in[I_WIN], INW, (bf16_t*)(ws + W_WTA), DM, NTA * 256, DM, tile, ctr, G, c);
    tr_matrix<0>(p.in[I_WMKV], 2048, (bf16_t*)(ws + W_WTA) + (size_t)NTA * 256 * DM, DM, 2048, DM, tile, ctr, G, c);
    for (int b = 0; b < NBATCH; ++b)
        tr_matrix<0>(p.in[I_CMV] + (size_t)b * 256 * MW, MW, (bf16_t*)(ws + W_VT) + (size_t)(8 + b) * MW * 256, 256, MW, 256, tile, ctr, G, c);
    conv_rows(p.in[I_XP], XB, (size_t)MP * DM / 8, g0, gs);
    conv_rows(p.in[I_XS], XB + (size_t)MP * DM, (size_t)MS * DM / 8, g0, gs);
    conv_rows(p.in[I_MEM], XB + (size_t)MROWS * DM, (size_t)MM * DM / 8, g0, gs);
    conv_rows(p.in[I_CMK], (bf16_t*)(ys + Y_MKB) + (size_t)2048 * MW, (size_t)2048 * MW / 8, g0, gs);
    {
        bf16_t* KS = (bf16_t*)(ys + Y_KS); bf16_t* VS = (bf16_t*)(ys + Y_VS); const float* ck = p.in[I_CFK]; const float* cv = p.in[I_CFV];
        const size_t n8 = (size_t)NBATCH * PAST * FW / 8;
        for (size_t i = g0; i < n8; i += gs) { const size_t e = i * 8, row = e / FW, col = e % FW, b = row / PAST, pp = row % PAST; const size_t d = ((b * SKVS + pp) * FW + col);
            *(u32x4*)(KS + d) = pack8u(*(const f32x4*)(ck + e), *(const f32x4*)(ck + e + 4)); *(u32x4*)(VS + d) = pack8u(*(const f32x4*)(cv + e), *(const f32x4*)(cv + e + 4)); }
    }
}

enum { KQ = 0, KK, KV, KGF, KCH, KBG, KMQ, KGM, KF, KMK, KMV };
struct SchedB {
    int G, c; const char* XB; const char* WTA;
    __device__ __forceinline__ bool next(int i, Unit& u) const {
        const int NU1 = NPAN * NTA, NU2 = 64; const long L = (long)i * G + c; if (L >= NU1 + NU2) return false;
        int pm, pn;
        if (L < NU1) { int wgid = (int)L; const int nwg = NU1; { const int q = nwg / 8, r = nwg % 8, xcd = wgid % 8, off = wgid / 8; wgid = (xcd < r ? xcd * (q + 1) : r * (q + 1) + (xcd - r) * q) + off; }
            const int nig = 8 * NTA, gid = wgid / nig, fm = gid * 8, gsz = (NPAN - fm) < 8 ? (NPAN - fm) : 8; pm = fm + ((wgid % nig) % gsz); pn = (wgid % nig) / gsz; }
        else { const int l2 = (int)L - NU1; pm = NPAN + (l2 & 7); pn = NTA + (l2 >> 3); }
        u.pm = pm; u.pn = pn; u.lda = DM; u.ldb = DM; u.nt = DM / BK;
        u.A = XB + (size_t)pm * 256 * DM * 2; u.B = WTA + (size_t)pn * 256 * DM * 2;
        int kind, aux;
        if (pn < 6) { kind = KQ; aux = pn; } else if (pn < 12) { kind = KK; aux = pn - 6; } else if (pn < 18) { kind = KV; aux = pn - 12; } else if (pn < 24) { kind = KGF; aux = pn - 18; }
        else if (pn < 36) { kind = KCH; aux = pn - 24; } else if (pn < 48) { kind = KBG; aux = pn - 36; } else if (pn < 52) { kind = KMQ; aux = pn - 48; } else if (pn < 56) { kind = KGM; aux = pn - 52; }
        else if (pn < 57) { kind = KF; aux = 0; } else if (pn < 61) { kind = KMK; aux = pn - 57; } else { kind = KMV; aux = pn - 61; }
        u.kind = kind; u.aux = aux; return true;
    }
};
struct EpiB {
    float* out; unsigned char* ws; const float* fbf;
    __device__ __forceinline__ void operator()(const f32x4 (&acc)[2][2][4][2], const Unit& u, int wr, int wc, int fr, int fq, LAS unsigned char*) const {
        unsigned char* ys = (unsigned char*)out;
        const int kind = u.kind, aux = u.aux, rbase = u.pm * 256 + wr * 64 + fr, cl = wc * 32 + fq * 8;
        const bool prompt = u.pm < 64;
        if (kind == KQ || kind == KGF || kind == KMQ || kind == KGM) {
            bf16_t* dst; int ld;
            if (kind == KQ) { dst = (bf16_t*)(ws + W_QB); ld = FW; } else if (kind == KGF) { dst = (bf16_t*)(ws + W_SGF); ld = FW; } else if (kind == KMQ) { dst = (bf16_t*)(ys + Y_MQ); ld = MW; } else { dst = (bf16_t*)(ys + Y_SGM); ld = MW; }
            const bool act = (kind == KGF || kind == KGM);
#pragma unroll
            for (int ai = 0; ai < 2; ++ai)
#pragma unroll
                for (int m = 0; m < 4; ++m) { bf16_t* rp = dst + (size_t)(rbase + ai * 128 + m * 16) * ld + aux * 256 + cl;
#pragma unroll
                    for (int bj = 0; bj < 2; ++bj) { f32x4 a = acc[ai][bj][m][0], b = acc[ai][bj][m][1];
                        if (act) {
#pragma unroll
                            for (int j = 0; j < 4; ++j) { a[j] = siluf_(a[j]); b[j] = siluf_(b[j]); } }
                        *(u32x4*)(rp + bj * 128) = pack8u(a, b); } }
        } else if (kind == KK || kind == KV) {
#pragma unroll
            for (int ai = 0; ai < 2; ++ai)
#pragma unroll
                for (int m = 0; m < 4; ++m) { const int row = rbase + ai * 128 + m * 16; float* fo; bf16_t* bo;
                    if (prompt) { fo = out + (kind == KK ? O_FKP : O_FVP) + (size_t)row * FW; bo = (bf16_t*)(ws + (kind == KK ? W_KB : W_VB)) + (size_t)row * FW; }
                    else { const int rs = row - MP; fo = out + (kind == KK ? O_FKS : O_FVS) + (size_t)rs * FW; bo = (bf16_t*)(ys + (kind == KK ? Y_KS : Y_VS)) + ((size_t)(rs >> 6) * SKVS + PAST + (rs & 63)) * FW; }
#pragma unroll
                    for (int bj = 0; bj < 2; ++bj) { const int col = aux * 256 + bj * 128 + cl; const f32x4 a = acc[ai][bj][m][0], b = acc[ai][bj][m][1];
                        *(f32x4*)(fo + col) = a; *(f32x4*)(fo + col + 4) = b; *(u32x4*)(bo + col) = pack8u(a, b); } }
        } else if (kind == KCH) {
            bf16_t* U = (bf16_t*)(ws + W_U);
#pragma unroll
            for (int ai = 0; ai < 2; ++ai)
#pragma unroll
                for (int m = 0; m < 4; ++m) { const int row = rbase + ai * 128 + m * 16; const int ch = aux * 128 + cl;
                    const f32x4 a = acc[ai][0][m][0] * acc[ai][1][m][0], b = acc[ai][0][m][1] * acc[ai][1][m][1];
                    *(u32x4*)(U + (size_t)row * FW + ch) = pack8u(a, b);
                    float* tp = nullptr;
                    if (prompt) { const int s = row & (SEQ - 1); if (s >= SEQ - 2) tp = out + O_CVP + ((size_t)(row >> 11) * 2 + (s - (SEQ - 2))) * FW + ch; }
                    else { const int rs = row - MP, t = rs & 63; if (t >= DECS - 2) tp = out + O_CVS + ((size_t)(rs >> 6) * 2 + (t - (DECS - 2))) * FW + ch; }
                    if (tp) { *(f32x4*)tp = a; *(f32x4*)(tp + 4) = b; } }
        } else if (kind == KBG) {
            bf16_t* BG = (bf16_t*)(ws + W_BGS);
#pragma unroll
            for (int ai = 0; ai < 2; ++ai)
#pragma unroll
                for (int m = 0; m < 4; ++m) { const int row = rbase + ai * 128 + m * 16; const int ch = aux * 128 + cl; f32x4 a, b;
#pragma unroll
                    for (int j = 0; j < 4; ++j) { a[j] = acc[ai][0][m][0][j] * siluf_(acc[ai][1][m][0][j]); b[j] = acc[ai][0][m][1][j] * siluf_(acc[ai][1][m][1][j]); }
                    *(u32x4*)(BG + (size_t)row * FW + ch) = pack8u(a, b); }
        } else if (kind == KF) {
            if (wc == 0 && fq < 2) {
#pragma unroll
                for (int ai = 0; ai < 2; ++ai)
#pragma unroll
                    for (int m = 0; m < 4; ++m) { const int row = rbase + ai * 128 + m * 16; float* lp = prompt ? out + O_FLP + (size_t)row * NH : out + O_FLS + (size_t)(row - MP) * NH;
#pragma unroll
                        for (int n = 0; n < 2; ++n)
#pragma unroll
                            for (int j = 0; j < 4; ++j) { const int col = fq * 8 + n * 4 + j; if (col < NH) { const float x = acc[ai][0][m][n][j] + fbf[col];
                                lp[col] = (x < 0.f) ? x - log1pf(expf(x)) : -log1pf(expf(-x)); } } }
            }
        } else {
#pragma unroll
            for (int ai = 0; ai < 2; ++ai)
#pragma unroll
                for (int m = 0; m < 4; ++m) { const int rm = rbase + ai * 128 + m * 16 - MROWS; float* fo = out + (kind == KMK ? O_MKP : O_MVP) + (size_t)rm * MW;
#pragma unroll
                    for (int bj = 0; bj < 2; ++bj) { const int col = aux * 256 + bj * 128 + cl; const f32x4 a = acc[ai][bj][m][0], b = acc[ai][bj][m][1];
                        *(f32x4*)(fo + col) = a; *(f32x4*)(fo + col + 4) = b;
                        if (kind == KMK) { *(u32x4*)((bf16_t*)(ys + Y_MKB) + (size_t)rm * MW + col) = pack8u(a, b); }
                        else { bf16_t* vt = (bf16_t*)(ws + W_VT) + (size_t)(rm >> 8) * MW * 256 + (rm & 255); const u32x4 w = pack8u(a, b); const unsigned ww[4] = {w.x, w.y, w.z, w.w};
#pragma unroll
                            for (int e = 0; e < 8; ++e) { const int lc = col + e; const int rp = (lc & ~31) + perm32inv(lc & 31); vt[(size_t)rp * 256] = (bf16_t)((e & 1) ? (ww[e >> 1] >> 16) : (ww[e >> 1] & 0xffffu)); } } } }
        }
    }
};

namespace att {
constexpr int D = 128, LDQ = FW, NW = 8, QBLK = 32, KVBLK = 64, QB = NW * QBLK;
constexpr int SHM_V = KVBLK * D * 2, SHM_K = KVBLK * D * 2;
constexpr int OFF_LI = 2 * SHM_V + 2 * SHM_K, OFF_KX = OFF_LI + NW * 64 * 4, OFF_CS = OFF_KX + 2048 * 4, OFF_END = OFF_CS + 256;
static_assert(OFF_END <= LDS_STAGE, "attention LDS");
constexpr float SCALE = 0.08838834764831845f, THR = 8.f;
#define KSWZ(row, colB) ((row) * 256 + ((colB) ^ (((row) & 7) << 4)))
#define SBAR() __builtin_amdgcn_sched_barrier(0)
__device__ __forceinline__ int v_st(int k, int c) { const int kk = (k & ~0xC) | ((k & 4) << 1) | ((k & 8) >> 1); return ((kk >> 3) * 4 + (c >> 5)) * 512 + ((kk & 7) * 32 + (c & 31)) * 2; }
__device__ __forceinline__ int v_rd_base(int lane) { return ((lane & 3) << 3) | (((lane >> 2) & 3) << 6) | (((lane >> 4) & 1) << 5) | (((lane >> 5) & 1) << 8); }
constexpr int v_rd_off(int d0, int ks, int half) { return d0 * 512 + ks * 4096 + half * 2048; }
__device__ __forceinline__ int crow(int r, int hi) { return (r & 3) + 8 * (r >> 2) + 4 * hi; }
__device__ __forceinline__ bf16x8 load8(const bf16_t* p) { return *reinterpret_cast<const bf16x8*>(p); }
__device__ __forceinline__ void mask_tile(f32x16& p0, f32x16& p1, int dq, unsigned W) {
    const float NEG = -__builtin_inff();
#pragma unroll
    for (int r = 0; r < 16; ++r) { const int c = (r & 3) + 8 * (r >> 2); if ((unsigned)(dq - c) >= W) p0[r] = NEG; if ((unsigned)(dq - c - 32) >= W) p1[r] = NEG; }
}
__device__ __forceinline__ void partialSM(f32x16& p0, f32x16& p1, float& m_reg, float& mn, float& alpha) {
    float pmax = p0[0]; for (int r = 1; r < 16; ++r) pmax = fmaxf(pmax, p0[r]); for (int r = 0; r < 16; ++r) pmax = fmaxf(pmax, p1[r]);
    { auto rr = __builtin_amdgcn_permlane32_swap(__float_as_uint(pmax), __float_as_uint(pmax), false, false); pmax = fmaxf(__uint_as_float(rr[0]), __uint_as_float(rr[1])); }
    constexpr float C2 = 1.4426950408889634f * SCALE;
    if (__builtin_expect(__all((pmax - m_reg) * SCALE <= THR), 1)) { mn = m_reg; alpha = 1.f; }
    else { mn = fmaxf(m_reg, pmax); alpha = __builtin_amdgcn_exp2f((m_reg - mn) * C2); m_reg = mn; }
    const float mnL = -mn * C2;
    for (int r = 0; r < 16; ++r) p0[r] = fmaf(p0[r], C2, mnL); for (int r = 0; r < 16; ++r) p1[r] = fmaf(p1[r], C2, mnL);
    for (int r = 0; r < 16; ++r) p0[r] = __builtin_amdgcn_exp2f(p0[r]);
}
__device__ __forceinline__ void finishSM(f32x16& p0, f32x16& p1, float alpha, float& l_reg, bf16x8& pa0, bf16x8& pa1, bf16x8& pa2, bf16x8& pa3) {
    for (int r = 0; r < 16; ++r) p1[r] = __builtin_amdgcn_exp2f(p1[r]);
    float ps = 0; for (int r = 0; r < 16; ++r) ps += p0[r]; for (int r = 0; r < 16; ++r) ps += p1[r];
    { auto rr = __builtin_amdgcn_permlane32_swap(__float_as_uint(ps), __float_as_uint(ps), false, false); ps = __uint_as_float(rr[0]) + __uint_as_float(rr[1]); }
    l_reg = l_reg * alpha + ps;
#define PK4(P, B_, OUT) do { unsigned a0 = cvtpk(P[B_+0], P[B_+1]), a1 = cvtpk(P[B_+2], P[B_+3]);                          \
        unsigned b0 = cvtpk(P[B_+4], P[B_+5]), b1 = cvtpk(P[B_+6], P[B_+7]);                                             \
        auto r0 = __builtin_amdgcn_permlane32_swap(a0, b0, false, false); auto r1 = __builtin_amdgcn_permlane32_swap(a1, b1, false, false); \
        u32x4 w = {r0[0], r1[0], r0[1], r1[1]}; OUT = *reinterpret_cast<bf16x8*>(&w); } while (0)
    PK4(p0, 0, pa0); PK4(p0, 8, pa1); PK4(p1, 0, pa2); PK4(p1, 8, pa3);
#undef PK4
}
template <int KB>
__device__ __forceinline__ void qkt(f32x16& p0, f32x16& p1, const char* K_lds, int r32, int hi, const bf16x8* qr, const float* bt) {
#pragma unroll
    for (int g = 0; g < 4; ++g) { const f32x4 a = *(const f32x4*)(bt + 8 * g), b = *(const f32x4*)(bt + 32 + 8 * g);
        p0[4 * g] = a[0]; p0[4 * g + 1] = a[1]; p0[4 * g + 2] = a[2]; p0[4 * g + 3] = a[3]; p1[4 * g] = b[0]; p1[4 * g + 1] = b[1]; p1[4 * g + 2] = b[2]; p1[4 * g + 3] = b[3]; }
    const char* kb[4];
#pragma unroll
    for (int dd = 0; dd < 4; ++dd) kb[dd] = K_lds + KB * SHM_K + KSWZ(r32, (dd * 16 + hi * 8) * 2);
#pragma unroll
    for (int d0 = 0; d0 < 8; ++d0) { const char* a = kb[d0 & 3] + (d0 >> 2) * 128;
        bf16x8 b0 = *reinterpret_cast<const bf16x8*>(a);
        bf16x8 b1 = *reinterpret_cast<const bf16x8*>(a + 32 * 256);
        p0 = __builtin_amdgcn_mfma_f32_32x32x16_bf16(b0, qr[d0], p0, 0, 0, 0);
        p1 = __builtin_amdgcn_mfma_f32_32x32x16_bf16(b1, qr[d0], p1, 0, 0, 0); }
}
template <int VB>
__device__ __forceinline__ void pv_tile(f32x16* o, int vb0, bf16x8 pa0, bf16x8 pa1, bf16x8 pa2, bf16x8 pa3) {
#define TRRD(dst, off) asm volatile("ds_read_b64_tr_b16 %0, %1 offset:%2" : "=&v"(dst) : "v"(vb0), "i"(off) : "memory")
#define PV_D0(d0) do { s16x4 l0, l1, l2, l3, h0, h1, h2, h3; constexpr int b_ = VB * SHM_V + v_rd_off(d0, 0, 0); \
        TRRD(l0, b_); TRRD(h0, b_ + 2048); TRRD(l1, b_ + 4096); TRRD(h1, b_ + 6144); TRRD(l2, b_ + 8192); TRRD(h2, b_ + 10240); TRRD(l3, b_ + 12288); TRRD(h3, b_ + 14336); \
        asm volatile("s_waitcnt lgkmcnt(0)" ::: "memory"); SBAR(); \
        o[d0] = __builtin_amdgcn_mfma_f32_32x32x16_bf16(pa0, (bf16x8){l0[0], l0[1], l0[2], l0[3], h0[0], h0[1], h0[2], h0[3]}, o[d0], 0, 0, 0);   \
        o[d0] = __builtin_amdgcn_mfma_f32_32x32x16_bf16(pa1, (bf16x8){l1[0], l1[1], l1[2], l1[3], h1[0], h1[1], h1[2], h1[3]}, o[d0], 0, 0, 0);   \
        o[d0] = __builtin_amdgcn_mfma_f32_32x32x16_bf16(pa2, (bf16x8){l2[0], l2[1], l2[2], l2[3], h2[0], h2[1], h2[2], h2[3]}, o[d0], 0, 0, 0);   \
        o[d0] = __builtin_amdgcn_mfma_f32_32x32x16_bf16(pa3, (bf16x8){l3[0], l3[1], l3[2], l3[3], h3[0], h3[1], h3[2], h3[3]}, o[d0], 0, 0, 0); } while (0)
    PV_D0(0); PV_D0(1); PV_D0(2); PV_D0(3);
#undef PV_D0
#undef TRRD
}
struct BlockRef { const bf16_t* Q; const bf16_t* K; const bf16_t* V; bf16_t* O; int P0, skv, nvalid; };
struct Seam { bf16x8 qr[8]; bf16x8 st_v0, st_v1, st_k0, st_k1; };
#define ROW(p, k0, rr) ((p) + (size_t)((k0) + (rr)) * LDQ + sc)
#define VMW() asm volatile("s_waitcnt vmcnt(0)" ::: "memory")
#define VMWN(n) asm volatile("s_waitcnt vmcnt(%0)" :: "i"(n) : "memory")
#define SLOAD_H(Kp, Vp, k0) do { S.st_v0 = load8(ROW(Vp, k0, sr)); S.st_v1 = load8(ROW(Vp, k0, 32 + sr)); S.st_k0 = load8(ROW(Kp, k0, sr)); S.st_k1 = load8(ROW(Kp, k0, 32 + sr)); } while (0)
#define SWRITE_HK(bf) do { *(bf16x8*)(K_lds + (bf) * SHM_K + kws) = S.st_k0; *(bf16x8*)(K_lds + (bf) * SHM_K + kws + 32 * 256) = S.st_k1; } while (0)
#define SWRITE_HV(bf) do { *(bf16x8*)(V_lds + (bf) * SHM_V + vst0) = S.st_v0; *(bf16x8*)(V_lds + (bf) * SHM_V + vst1) = S.st_v1; } while (0)
#define SWRITE_H(bf) do { SWRITE_HV(bf); SWRITE_HK(bf); } while (0)
__device__ __forceinline__ void prime(const BlockRef& cur, char* lds, Seam& S) {
    const int tid = otid(), wid = __builtin_amdgcn_readfirstlane(tid >> 6), lane = tid & 63, r32 = lane & 31, hi = lane >> 5;
    const int sr = tid >> 4, sc = (tid & 15) * 8, kws = KSWZ(sr, sc * 2); char* K_lds = lds + 2 * SHM_V;
    for (int d0 = 0; d0 < 8; ++d0) S.qr[d0] = load8(cur.Q + (size_t)(wid * QBLK + r32) * LDQ + d0 * 16 + hi * 8);
    SLOAD_H(cur.K, cur.V, 0); VMW(); SWRITE_HK(0);
    __syncthreads();
}
__device__ __forceinline__ void block(const BlockRef& cur, const BlockRef& nxt, char* lds, Seam& S) {
    const int tid = otid(), wid = __builtin_amdgcn_readfirstlane(tid >> 6), lane = tid & 63, r32 = lane & 31, hi = lane >> 5;
    constexpr int W = 1 << 24;
    int j_hi = (cur.P0 + QB - 1) / KVBLK + 1; if (j_hi > cur.skv / KVBLK) j_hi = cur.skv / KVBLK;
    const int NT = j_hi;
    const int qlo = cur.P0 + wid * QBLK, qm = qlo + r32 - 4 * hi;
    char* V_lds = lds; char* K_lds = lds + 2 * SHM_V; const float* KXf = (const float*)(lds + OFF_KX) + 4 * hi;
    float* wsl = (float*)(lds + OFF_LI) + wid * 64; float* li_l = wsl, * al_l = wsl + 32;
    float m_reg = -1e30f, l_reg = 0; f32x16 o[4] = {};
    const int sr = tid >> 4, sc = (tid & 15) * 8, vst0 = v_st(sr, sc), vst1 = v_st(32 + sr, sc), kws = KSWZ(sr, sc * 2);
    const int vb0 = (int)(uintptr_t)V_lds + v_rd_base(lane);
    const bf16_t* Kh = cur.K; const bf16_t* Vh = cur.V;
#define RESC(a) do { if (__any((a) < 1.f)) { if (hi == 0) al_l[r32] = (a); asm volatile("s_waitcnt lgkmcnt(0)" ::: "memory");              \
                     for (int d_ = 0; d_ < 4; ++d_) for (int r = 0; r < 16; ++r) o[d_][r] *= al_l[crow(r, hi)]; } } while (0)
#define KBASE(t) ((t) * KVBLK)
#define MASKT(P0_, P1_, t) do { const int kb_ = KBASE(t); if (kb_ + KVBLK - 1 > qlo) mask_tile(P0_, P1_, qm - kb_, (unsigned)W); } while (0)
#define SEAM_K0() do { VMWN(8); SWRITE_HK(0); SBAR(); } while (0)
    f32x16 pA0, pA1, pB0, pB1; float mnA, mnB, alA, alB; bf16x8 pa0, pa1, pa2, pa3;
    SWRITE_HV(0); SBAR();
    if (NT > 1) { SLOAD_H(Kh, Vh, KBASE(1)); }
    SBAR(); qkt<0>(pA0, pA1, K_lds, r32, hi, S.qr, KXf + KBASE(0));
    MASKT(pA0, pA1, 0); partialSM(pA0, pA1, m_reg, mnA, alA);
    if (NT > 1) { VMW(); SWRITE_H(1); }
    __syncthreads();
#define HALF_STEP(PX0, PX1, mnX, alX, PY0, PY1, alY, t, KB, VB, SB) do {                                                      \
        SBAR(); qkt<KB>(PX0, PX1, K_lds, r32, hi, S.qr, KXf + KBASE(t));                                              \
        finishSM(PY0, PY1, alY, l_reg, pa0, pa1, pa2, pa3); SBAR();                                                           \
        if ((t) + 1 < NT) { SLOAD_H(Kh, Vh, KBASE((t) + 1)); SBAR(); }                                                        \
        pv_tile<VB>(o, vb0, pa0, pa1, pa2, pa3); MASKT(PX0, PX1, (t)); partialSM(PX0, PX1, m_reg, mnX, alX);                  \
        __syncthreads();                                                                                                      \
        if ((t) + 1 < NT) { VMW(); SWRITE_H(SB); }                                                                            \
        RESC(alX); __syncthreads(); } while (0)
    for (int t = 1; t + 1 < NT; t += 2) {
        HALF_STEP(pB0, pB1, mnB, alB, pA0, pA1, alA, t, 1, 0, 0);
        HALF_STEP(pA0, pA1, mnA, alA, pB0, pB1, alB, t + 1, 0, 1, 1);
    }
    const bool even = (NT & 1) == 0;
    if (even) { SBAR(); qkt<1>(pB0, pB1, K_lds, r32, hi, S.qr, KXf + KBASE(NT - 1)); SBAR(); }
    SLOAD_H(nxt.K, nxt.V, 0); SBAR();
#pragma unroll
    for (int d0 = 0; d0 < 8; ++d0) S.qr[d0] = load8(nxt.Q + (size_t)(wid * QBLK + r32) * LDQ + d0 * 16 + hi * 8);
    SBAR();
    finishSM(pA0, pA1, alA, l_reg, pa0, pa1, pa2, pa3); SBAR();
    pv_tile<0>(o, vb0, pa0, pa1, pa2, pa3);
    if (even) { MASKT(pB0, pB1, NT - 1); partialSM(pB0, pB1, m_reg, mnB, alB); __syncthreads(); RESC(alB);
        finishSM(pB0, pB1, alB, l_reg, pa0, pa1, pa2, pa3); SBAR(); pv_tile<1>(o, vb0, pa0, pa1, pa2, pa3); }
    SBAR(); SEAM_K0();
    if (hi == 0) li_l[r32] = l_reg; asm volatile("s_waitcnt lgkmcnt(0)" ::: "memory");
    int r32e = r32, hie = hi; asm volatile("" : "+v"(r32e), "+v"(hie));
    const int lane_off = 4 * hie * LDQ + r32e;
    bf16_t* Ow = cur.O + (size_t)(wid * QBLK) * LDQ;
    const int nv = cur.nvalid - wid * QBLK;
#pragma unroll
    for (int r = 0; r < 16; ++r) { const int orow = crow(r, hi); const float rli = __builtin_amdgcn_rcpf(li_l[orow]);
        if (orow < nv) {
#pragma unroll
            for (int d0 = 0; d0 < 4; ++d0) { bf16_t* gp = Ow + (lane_off + ((r & 3) + 8 * (r >> 2)) * LDQ + d0 * 32); const float v = o[d0][r] * rli * bf2f(*gp);
                const float vn = __shfl_xor(v, 1);
                if ((r32e & 1) == 0) *(unsigned*)gp = cvtpk(v, vn); } } }
    __syncthreads();
#undef RESC
#undef KBASE
#undef MASKT
#undef SEAM_K0
#undef HALF_STEP
}
#undef ROW
#undef VMW
#undef VMWN
#undef SLOAD_H
#undef SWRITE_HK
#undef SWRITE_HV
#undef SWRITE_H

__device__ __forceinline__ void build_kx(const Params& p, char* lds, int b, int h, bool sample, int P0, int nkeys) {
    int tid = threadIdx.x; asm volatile("" : "+v"(tid));
    const int wid = tid >> 6, lane = tid & 63;
    float* cs = (float*)(lds + OFF_CS);
    float v[4];
#pragma unroll
    for (int e = 0; e < 4; ++e) { const int key = tid * 4 + e; float x = 0.f;
        if (key < nkeys) { if (!sample) x = p.out[O_FLP + ((size_t)b * SEQ + key) * NH + h]; else x = (key < PAST) ? p.in[I_CFL][((size_t)b * PAST + key) * NH + h] : p.out[O_FLS + ((size_t)b * DECS + (key - PAST)) * NH + h]; }
        v[e] = x; }
    v[1] += v[0]; v[2] += v[1]; v[3] += v[2];
    float tot = v[3], inc = tot;
#pragma unroll
    for (int s = 1; s < 64; s <<= 1) { const float t = __shfl_up(inc, s); if (lane >= s) inc += t; }
    if (lane == 63) cs[wid] = inc;
    __syncthreads();
    float off = inc - tot;
    for (int w = 0; w < wid; ++w) off += cs[w];
#pragma unroll
    for (int e = 0; e < 4; ++e) { v[e] += off; if (tid * 4 + e == P0) cs[8] = v[e]; }
    __syncthreads();
    const float c0 = cs[8];
#pragma unroll
    for (int e = 0; e < 4; ++e) ((float*)(lds + OFF_KX))[tid * 4 + e] = (c0 - v[e]) * (1.0f / SCALE);
}
}

__device__ __forceinline__ att::BlockRef fox_ref(const Params& p, int bh, int qb) {
    unsigned char* ws = p.ws; unsigned char* ys = (unsigned char*)p.out; const int b = bh / NH, h = bh % NH; att::BlockRef r;
    if (qb < 8) { const size_t row0 = (size_t)b * SEQ; r.Q = (const bf16_t*)(ws + W_QB) + (row0 + qb * 256) * FW + h * 128; r.K = (const bf16_t*)(ws + W_KB) + row0 * FW + h * 128;
        r.V = (const bf16_t*)(ws + W_VB) + row0 * FW + h * 128; r.O = (bf16_t*)(ws + W_SGF) + (row0 + qb * 256) * FW + h * 128; r.P0 = qb * 256; r.skv = SEQ; r.nvalid = 256; }
    else { const size_t row0 = (size_t)MP + b * DECS; r.Q = (const bf16_t*)(ws + W_QB) + row0 * FW + h * 128; r.K = (const bf16_t*)(ys + Y_KS) + (size_t)b * SKVS * FW + h * 128;
        r.V = (const bf16_t*)(ys + Y_VS) + (size_t)b * SKVS * FW + h * 128; r.O = (bf16_t*)(ws + W_SGF) + row0 * FW + h * 128; r.P0 = PAST; r.skv = SKVS; r.nvalid = DECS; }
    return r;
}
__device__ __forceinline__ void phase_fox(const Params& p, char* lds) {
    static constexpr unsigned char BINS[8][8] = { {0x07, 0x06, 0, 0, 0, 0, 0, 0}, {0x17, 0x16, 0, 0, 0, 0, 0, 0}, {0x27, 0x26, 0, 0, 0, 0, 0, 0},
        {0x05, 0x04, 0x08, 0, 0, 0, 0, 0}, {0x15, 0x14, 0x18, 0, 0, 0, 0, 0}, {0x25, 0x24, 0x28, 0, 0, 0, 0, 0},
        {0x03, 0x13, 0x23, 0x02, 0, 0, 0, 0}, {0x12, 0x22, 0x01, 0x11, 0x21, 0x00, 0x10, 0x20} };
    static constexpr unsigned char BINN[8] = {2, 2, 2, 3, 3, 3, 4, 8};
    att::Seam S;
    for (int vb = blockIdx.x; vb < 256; vb += gridDim.x) {
        const int tri = vb >> 3, bin = vb & 7, n = BINN[bin];
        int it = BINS[bin][0]; att::BlockRef cur = fox_ref(p, tri * 3 + (it >> 4), it & 15);
        att::prime(cur, lds, S);
        for (int k = 0; k < n; ++k) {
            att::BlockRef nxt = cur; int itn = it;
            if (k + 1 < n) { itn = BINS[bin][k + 1]; nxt = fox_ref(p, tri * 3 + (itn >> 4), itn & 15); }
            const int bh = tri * 3 + (it >> 4);
            att::build_kx(p, lds, bh / NH, bh % NH, (it & 15) == 8, cur.P0, (it & 15) == 8 ? SKVS : cur.P0 + 256);
            __syncthreads();
            att::block(cur, nxt, lds, S);
            cur = nxt; it = itn;
        }
        asm volatile("s_waitcnt vmcnt(0)" ::: "memory");
        __syncthreads();
    }
}

struct SchedS {
    int G, c; const char* MQ; const char* MKB;
    __device__ __forceinline__ bool next(int i, Unit& u) const {
        const int L = i * G + c; if (L >= 288) return false;
        u.lda = MW; u.ldb = MW; u.nt = 4; u.kind = 0;
        if (L < 256) { const int pm = L >> 2, h = L & 3; u.pm = pm; u.pn = h; u.aux = -1; u.A = MQ + ((size_t)pm * 256 * MW + h * 256) * 2; u.B = MKB + ((size_t)(pm >> 3) * 256 * MW + h * 256) * 2; }
        else { const int idx = L - 256, b = idx >> 2, h = idx & 3; u.pm = 64 + (b >> 2); u.pn = h; u.aux = b & 3; u.A = MQ + ((size_t)u.pm * 256 * MW + h * 256) * 2; u.B = MKB + ((size_t)(2048 + b * 256) * MW + h * 256) * 2; }
        return true;
    }
};
struct EpiS {
    bf16_t* P;
    __device__ __forceinline__ void operator()(const f32x4 (&acc)[2][2][4][2], const Unit& u, int wr, int wc, int fr, int fq, LAS unsigned char* lds) const {
        typedef float f32x2v __attribute__((ext_vector_type(2)));
        LAS f32x2v* X = (LAS f32x2v*)(lds + LDS_X);
        constexpr float C2 = 1.4426950408889634f * 0.0625f;
        float mw[2][4];
#pragma unroll
        for (int ai = 0; ai < 2; ++ai)
#pragma unroll
            for (int m = 0; m < 4; ++m) { float mx = -3.0e38f;
#pragma unroll
                for (int bj = 0; bj < 2; ++bj)
#pragma unroll
                    for (int n = 0; n < 2; ++n) { const f32x4 x = acc[ai][bj][m][n]; mx = fmaxf(mx, fmaxf(fmaxf(x[0], x[1]), fmaxf(x[2], x[3]))); }
                mx = fmaxf(mx, __shfl_xor(mx, 16)); mx = fmaxf(mx, __shfl_xor(mx, 32));
                float s = 0.f;
#pragma unroll
                for (int bj = 0; bj < 2; ++bj)
#pragma unroll
                    for (int n = 0; n < 2; ++n) { const f32x4 x = acc[ai][bj][m][n];
#pragma unroll
                        for (int j = 0; j < 4; ++j) s += __builtin_amdgcn_exp2f((x[j] - mx) * C2); }
                s += __shfl_xor(s, 16); s += __shfl_xor(s, 32);
                mw[ai][m] = mx;
                if (fq == 0) X[(wr * 128 + ai * 64 + m * 16 + fr) * 4 + wc] = (f32x2v){mx, s}; }
        asm volatile("s_waitcnt lgkmcnt(0)" ::: "memory"); __builtin_amdgcn_s_barrier(); asm volatile("" ::: "memory");
        const int lo = (u.aux < 0) ? 0 : u.aux * 64, hiR = (u.aux < 0) ? 256 : lo + 64;
#pragma unroll
        for (int ai = 0; ai < 2; ++ai)
#pragma unroll
            for (int m = 0; m < 4; ++m) { const int rl = ai * 128 + wr * 64 + m * 16 + fr; const LAS f32x2v* xr = X + (wr * 128 + ai * 64 + m * 16 + fr) * 4;
                const f32x2v a = xr[0], b = xr[1], c = xr[2], d = xr[3];
                const float M = fmaxf(fmaxf(a.x, b.x), fmaxf(c.x, d.x));
                const float Lsum = a.y * __builtin_amdgcn_exp2f((a.x - M) * C2) + b.y * __builtin_amdgcn_exp2f((b.x - M) * C2) + c.y * __builtin_amdgcn_exp2f((c.x - M) * C2) + d.y * __builtin_amdgcn_exp2f((d.x - M) * C2);
                const float rl_ = __builtin_amdgcn_rcpf(Lsum);
                if (rl >= lo && rl < hiR) { bf16_t* rp = P + (size_t)(u.pm * 256 + rl) * MW + u.pn * 256 + wc * 32 + fq * 4;
#pragma unroll
                    for (int bj = 0; bj < 2; ++bj)
#pragma unroll
                        for (int n = 0; n < 2; ++n) { const f32x4 x = acc[ai][bj][m][n]; float e[4];
#pragma unroll
                            for (int j = 0; j < 4; ++j) e[j] = __builtin_amdgcn_exp2f((x[j] - M) * C2) * rl_;
                            *(u32x2*)(rp + bj * 128 + n * 16) = (u32x2){cvtpk(e[0], e[1]), cvtpk(e[2], e[3])}; } } }
        (void)mw;
    }
};

__device__ __forceinline__ void phase_conv(const Params& p) {
    unsigned char* ws = p.ws; const bf16_t* U = (const bf16_t*)(ws + W_U); bf16_t* BG = (bf16_t*)(ws + W_BGS);
    const float* cw = p.in[I_CW]; const float* cb = p.in[I_CB]; const float* st = p.in[I_SCONV];
    const size_t n = (size_t)MROWS * (FW / 8), g0 = (size_t)blockIdx.x * 512 + otid(), gs = (size_t)gridDim.x * 512;
    for (size_t i = g0; i < n; i += gs) { const int row = (int)(i / (FW / 8)), ch = (int)(i % (FW / 8)) * 8;
        float u0[8], u1[8], u2[8], g[8];
        unpack8(*(const u32x4*)(U + (size_t)row * FW + ch), u2); unpack8(*(const u32x4*)(BG + (size_t)row * FW + ch), g);
        int t; const float* s0 = nullptr;
        if (row < MP) t = row & (SEQ - 1); else { const int rs = row - MP; t = rs & 63; s0 = st + (size_t)(rs >> 6) * 2 * FW + ch; }
        if (t >= 1) unpack8(*(const u32x4*)(U + (size_t)(row - 1) * FW + ch), u1);
        else {
#pragma unroll
            for (int e = 0; e < 8; ++e) u1[e] = s0 ? s0[FW + e] : 0.f; }
        if (t >= 2) unpack8(*(const u32x4*)(U + (size_t)(row - 2) * FW + ch), u0);
        else {
#pragma unroll
            for (int e = 0; e < 8; ++e) u0[e] = s0 ? s0[(size_t)t * FW + e] : 0.f; }
        float o[8];
#pragma unroll
        for (int e = 0; e < 8; ++e) o[e] = g[e] * (cw[ch + e] * u0[e] + cw[FW + ch + e] * u1[e] + cw[2 * FW + ch + e] * u2[e] + cb[ch + e]);
        *(u32x4*)(BG + (size_t)row * FW + ch) = (u32x4){cvtpk(o[0], o[1]), cvtpk(o[2], o[3]), cvtpk(o[4], o[5]), cvtpk(o[6], o[7])}; }
}

struct SchedPV {
    int G, c; const char* P; const char* VT;
    __device__ __forceinline__ bool next(int i, Unit& u) const {
        const int L = i * G + c; if (L >= 288) return false;
        u.lda = MW; u.ldb = 256; u.nt = 4; u.kind = 0;
        if (L < 256) { const int pm = L >> 2, h = L & 3; u.pm = pm; u.pn = h; u.aux = -1; u.A = P + ((size_t)pm * 256 * MW + h * 256) * 2; u.B = VT + ((size_t)(pm >> 3) * MW + h * 256) * 256 * 2; }
        else { const int idx = L - 256, b = idx >> 2, h = idx & 3; u.pm = 64 + (b >> 2); u.pn = h; u.aux = b & 3; u.A = P + ((size_t)u.pm * 256 * MW + h * 256) * 2; u.B = VT + ((size_t)(8 + b) * MW + h * 256) * 256 * 2; }
        return true;
    }
};
struct EpiPV {
    bf16_t* SGM;
    __device__ __forceinline__ void operator()(const f32x4 (&acc)[2][2][4][2], const Unit& u, int wr, int wc, int fr, int fq, LAS unsigned char*) const {
        const int lo = (u.aux < 0) ? 0 : u.aux * 64, hiR = (u.aux < 0) ? 256 : lo + 64;
#pragma unroll
        for (int ai = 0; ai < 2; ++ai)
#pragma unroll
            for (int m = 0; m < 4; ++m) { const int rl = ai * 128 + wr * 64 + m * 16 + fr;
                if (rl >= lo && rl < hiR) { bf16_t* rp = SGM + (size_t)(u.pm * 256 + rl) * MW + u.pn * 256 + wc * 32 + fq * 8;
#pragma unroll
                    for (int bj = 0; bj < 2; ++bj) { float g[8]; unpack8(*(const u32x4*)(rp + bj * 128), g); const f32x4 a = acc[ai][bj][m][0], b = acc[ai][bj][m][1];
                        *(u32x4*)(rp + bj * 128) = (u32x4){cvtpk(a[0] * g[0], a[1] * g[1]), cvtpk(a[2] * g[2], a[3] * g[3]), cvtpk(b[0] * g[4], b[1] * g[5]), cvtpk(b[2] * g[6], b[3] * g[7])}; } } }
    }
};
__device__ __forceinline__ void phase_prep2(const Params& p, char* smem) {
    float* tile = (float*)smem; unsigned char* ws = p.ws; const int G = gridDim.x, c = blockIdx.x; int ctr = 0;
    bf16_t* WTC = (bf16_t*)(ws + W_WTC);
    tr_matrix<0>(p.in[I_WMG], 6144, (bf16_t*)(ws + W_WTM), DM, 6144, DM, tile, ctr, G, c);
    tr_matrix<0>(p.in[I_WFO], DM, WTC, 4096, DM, FW, tile, ctr, G, c);
    tr_matrix<0>(p.in[I_WCO], DM, WTC + FW, 4096, DM, FW, tile, ctr, G, c);
    tr_matrix<0>(p.in[I_WMO], DM, WTC + 2 * FW, 4096, DM, MW, tile, ctr, G, c);
    tr_matrix<0>(p.in[I_WO], DM, (bf16_t*)(ws + W_WTO), DM, DM, DM, tile, ctr, G, c);
}

struct SchedE1 {
    int G, c; const char* XB; const char* WTM; const char* WTC; const char* AF; const char* AC; const char* AM;
    __device__ __forceinline__ bool next(int i, Unit& u) const {
        const int tr = i / 6, s = i - tr * 6;
        int pm, pn;
        if (G == 256) { pm = 4 * ((c & 7) + 8 * tr) + ((c >> 3) & 3); pn = c >> 5; if (pm >= NPAN) return false; }
        else { const int T = tr * G + c; if (T >= NPAN * 8) return false; pn = T / NPAN; pm = T % NPAN; }
        const int br = s >> 1; u.pm = pm; u.pn = pn; u.kind = s; u.aux = br;
        if ((s & 1) == 0) { u.A = XB + (size_t)pm * 256 * DM * 2; u.B = WTM + ((size_t)br * DM + pn * 256) * DM * 2; u.lda = DM; u.ldb = DM; u.nt = DM / BK; }
        else { u.ldb = 4096; u.B = WTC + ((size_t)pn * 256 * 4096 + (br == 0 ? 0 : (br == 1 ? FW : 2 * FW))) * 2;
            if (br == 0) { u.A = AF + (size_t)pm * 256 * FW * 2; u.lda = FW; u.nt = FW / BK; } else if (br == 1) { u.A = AC + (size_t)pm * 256 * FW * 2; u.lda = FW; u.nt = FW / BK; }
            else { u.A = AM + (size_t)pm * 256 * MW * 2; u.lda = MW; u.nt = MW / BK; } }
        return true;
    }
};
struct EpiE1 {
    unsigned char* gs; unsigned char* msc; bf16_t* MB; const float* bmg;
    __device__ __forceinline__ void operator()(const f32x4 (&acc)[2][2][4][2], const Unit& u, int wr, int wc, int fr, int fq, LAS unsigned char*) const {
        int tid = threadIdx.x; asm volatile("" : "+v"(tid));
        const int s = u.kind, cl = wc * 32 + fq * 8;
        unsigned char* gsl = gs + (size_t)tid * 16; unsigned char* mscl = msc + (size_t)tid * 16;
        if ((s & 1) == 0) {
            const float* bp = bmg + u.aux * DM + u.pn * 256 + cl; f32x4 bv[2][2];
#pragma unroll
            for (int bj = 0; bj < 2; ++bj)
#pragma unroll
                for (int n = 0; n < 2; ++n) bv[bj][n] = *(const f32x4*)(bp + bj * 128 + n * 4);
#pragma unroll
            for (int ai = 0; ai < 2; ++ai)
#pragma unroll
                for (int bj = 0; bj < 2; ++bj)
#pragma unroll
                    for (int m = 0; m < 4; ++m) { f32x4 a = acc[ai][bj][m][0] + bv[bj][0], b = acc[ai][bj][m][1] + bv[bj][1];
#pragma unroll
                        for (int j = 0; j < 4; ++j) { a[j] = sigmoidf_(a[j]); b[j] = sigmoidf_(b[j]); }
                        *(u32x4*)(gsl + (((ai * 2 + bj) * 4 + m) * 8192)) = pack8u(a, b); asm volatile("" ::: "memory"); }
        } else {
#pragma unroll
            for (int ai = 0; ai < 2; ++ai)
#pragma unroll
                for (int bj = 0; bj < 2; ++bj)
#pragma unroll
                    for (int m = 0; m < 4; ++m) { const int k = (ai * 2 + bj) * 4 + m; float g[8]; unpack8(*(const u32x4*)(gsl + k * 8192), g);
                        f32x4 a = acc[ai][bj][m][0], b = acc[ai][bj][m][1];
#pragma unroll
                        for (int j = 0; j < 4; ++j) { a[j] *= g[j]; b[j] *= g[4 + j]; }
                        f32x4* mp = (f32x4*)(mscl + (k * 2) * 8192); f32x4* mq = (f32x4*)(mscl + (k * 2 + 1) * 8192);
                        if (s == 1) { *mp = a; *mq = b; }
                        else if (s == 3) { *mp = *mp + a; *mq = *mq + b; }
                        else { a = a + *mp; b = b + *mq; *(u32x4*)(MB + (size_t)(u.pm * 256 + ai * 128 + wr * 64 + m * 16 + fr) * DM + u.pn * 256 + bj * 128 + cl) = pack8u(a, b); }
                        if (m & 1) asm volatile("" ::: "memory"); }
        }
    }
};

struct SchedE2 {
    int G, c; const char* MB; const char* WTO;
    __device__ __forceinline__ bool next(int i, Unit& u) const {
        int pm, pn;
        if (G == 256) { pm = 4 * ((c & 7) + 8 * i) + ((c >> 3) & 3); pn = c >> 5; if (pm >= NPAN) return false; }
        else { const int T = i * G + c; if (T >= NPAN * 8) return false; pn = T / NPAN; pm = T % NPAN; } u.pm = pm; u.pn = pn; u.kind = 0; u.aux = 0; u.lda = DM; u.ldb = DM; u.nt = DM / BK;
        u.A = MB + (size_t)pm * 256 * DM * 2; u.B = WTO + (size_t)pn * 256 * DM * 2; return true;
    }
};
struct EpiE2 {
    float* out; const float* xp; const float* xs;
    __device__ __forceinline__ void operator()(const f32x4 (&acc)[2][2][4][2], const Unit& u, int wr, int wc, int fr, int fq, LAS unsigned char*) const {
        constexpr float ALPHA = 1.189207115002721f;
        const int cl = u.pn * 256 + wc * 32 + fq * 8;
#pragma unroll
        for (int ai = 0; ai < 2; ++ai)
#pragma unroll
            for (int m = 0; m < 4; ++m) { const int row = u.pm * 256 + ai * 128 + wr * 64 + m * 16 + fr; const float* xr; float* yr;
                if (row < MP) { xr = xp + (size_t)row * DM; yr = out + O_YP + (size_t)row * DM; } else { xr = xs + (size_t)(row - MP) * DM; yr = out + O_YS + (size_t)(row - MP) * DM; }
#pragma unroll
                for (int bj = 0; bj < 2; ++bj) { const int col = cl + bj * 128; const f32x4 x0 = *(const f32x4*)(xr + col), x1 = *(const f32x4*)(xr + col + 4);
                    *(f32x4*)(yr + col) = x0 * ALPHA + acc[ai][bj][m][0]; *(f32x4*)(yr + col + 4) = x1 * ALPHA + acc[ai][bj][m][1]; } }
    }
};

__device__ __forceinline__ void phase_ln(const Params& p) {
    const int tid = otid(), wid = tid >> 6, lane = tid & 63; const float* g = p.in[I_LNG]; const float* bb = p.in[I_LNB];
    for (int row = blockIdx.x * 8 + wid; row < MROWS; row += gridDim.x * 8) {
        float* yr = p.out + (row < MP ? O_YP + (size_t)row * DM : O_YS + (size_t)(row - MP) * DM);
        f32x4 v[8]; float s = 0.f;
#pragma unroll
        for (int i = 0; i < 8; ++i) { v[i] = *(const f32x4*)(yr + i * 256 + lane * 4); s += (v[i][0] + v[i][1]) + (v[i][2] + v[i][3]); }
#pragma unroll
        for (int o = 32; o >= 1; o >>= 1) s += __shfl_xor(s, o);
        const float mu = s * (1.0f / DM); float q = 0.f;
#pragma unroll
        for (int i = 0; i < 8; ++i) { const f32x4 d = v[i] - mu; q += (d[0] * d[0] + d[1] * d[1]) + (d[2] * d[2] + d[3] * d[3]); }
#pragma unroll
        for (int o = 32; o >= 1; o >>= 1) q += __shfl_xor(q, o);
        const float rstd = 1.0f / sqrtf(q * (1.0f / DM) + 1e-5f);
#pragma unroll
        for (int i = 0; i < 8; ++i) { const int col = i * 256 + lane * 4; const f32x4 gg = *(const f32x4*)(g + col), b4 = *(const f32x4*)(bb + col);
            *(f32x4*)(yr + col) = (v[i] - mu) * rstd * gg + b4; }
    }
}

#define GSYNC() do { asm volatile("s_waitcnt vmcnt(0)" ::: "memory"); grid.sync(); if (threadIdx.x < 64) { __builtin_amdgcn_fence(__ATOMIC_ACQUIRE, "agent"); asm volatile("s_waitcnt vmcnt(0)" ::: "memory"); } __syncthreads(); } while (0)
__global__ void __launch_bounds__(512) fwd_megakernel(Params p) {
    extern __shared__ __attribute__((aligned(16))) unsigned char smem[];
    cg::grid_group grid = cg::this_grid();
    LAS unsigned char* lds = (LAS unsigned char*)smem;
    unsigned char* ws = p.ws; unsigned char* ys = (unsigned char*)p.out;
    const int G = gridDim.x, c = blockIdx.x;

#ifndef PH
#define PH 0xFFFF
#endif
#if PH & 1
    phase_prep(p, (char*)smem);
#endif
    GSYNC();
#if PH & 2
    { SchedB S{G, c, (const char*)(ws + W_XB), (const char*)(ws + W_WTA)}; EpiB E{p.out, ws, p.in[I_FBF]}; gemm_phase(lds, S, E); }
#endif
    GSYNC();
#if PH & 4
    phase_fox(p, (char*)smem);
#endif
    __syncthreads();
#if PH & 8
    { SchedS S{G, c, (const char*)(ys + Y_MQ), (const char*)(ys + Y_MKB)}; EpiS E{(bf16_t*)(ws + W_P)}; gemm_phase(lds, S, E); }
#endif
#if PH & 16
    phase_conv(p);
#endif
    GSYNC();
#if PH & 32
    { SchedPV S{G, c, (const char*)(ws + W_P), (const char*)(ws + W_VT)}; EpiPV E{(bf16_t*)(ys + Y_SGM)}; gemm_phase(lds, S, E); }
#endif
    __syncthreads();
#if PH & 64
    phase_prep2(p, (char*)smem);
#endif
    GSYNC();
#if PH & 128
    { SchedE1 S{G, c, (const char*)(ws + W_XB), (const char*)(ws + W_WTM), (const char*)(ws + W_WTC), (const char*)(ws + W_SGF), (const char*)(ws + W_BGS), (const char*)(ys + Y_SGM)};
      EpiE1 E{ws + W_GS + (size_t)c * 131072, ws + W_MSC + (size_t)c * 262144, (bf16_t*)(ws + W_MB), p.in[I_BMG]}; gemm_phase(lds, S, E); }
#endif
    GSYNC();
#if PH & 256
    { SchedE2 S{G, c, (const char*)(ws + W_MB), (const char*)(ws + W_WTO)}; EpiE2 E{p.out, p.in[I_XP], p.in[I_XS]}; gemm_phase(lds, S, E); }
#endif
    GSYNC();
#if PH & 512
    phase_ln(p);
#endif
}

extern "C" void kernel_launch(void* const* d_in, const int* in_sizes, int n_in, void* d_out, int out_size, void* d_ws, size_t ws_size, hipStream_t stream) {
    static int grid_blocks = 0;
    if (grid_blocks == 0) {
        if (n_in != 22 || (size_t)out_size != O_END || ws_size < W_END) { fprintf(stderr, "kernel_launch: unexpected shapes (n_in %d, out %d, ws %zu, need %zu)\n", n_in, out_size, ws_size, (size_t)W_END); grid_blocks = -1; return; }
        int dev = 0, cus = 0, per_cu = 0;
        (void)hipGetDevice(&dev); (void)hipDeviceGetAttribute(&cus, hipDeviceAttributeMultiprocessorCount, dev);
        if (hipFuncSetAttribute((const void*)fwd_megakernel, hipFuncAttributeMaxDynamicSharedMemorySize, LDS_BYTES) != hipSuccess) { fprintf(stderr, "kernel_launch: hipFuncSetAttribute failed\n"); grid_blocks = -1; return; }
        if (hipOccupancyMaxActiveBlocksPerMultiprocessor(&per_cu, (const void*)fwd_megakernel, 512, LDS_BYTES) != hipSuccess || per_cu < 1) { fprintf(stderr, "kernel_launch: occupancy query says %d\n", per_cu); grid_blocks = -1; return; }
        int g = cus * per_cu; if (g > 256) g = 256; g &= ~7; if (g < 8) g = 8;
        grid_blocks = g;
    }
    if (grid_blocks < 0) return;
    Params p{};
    for (int i = 0; i < 22; ++i) p.in[i] = (const float*)d_in[i];
    p.out = (float*)d_out; p.ws = (unsigned char*)d_ws;
    void* args[] = {&p};
    hipError_t e = hipLaunchCooperativeKernel((const void*)fwd_megakernel, dim3(grid_blocks), dim3(512), args, LDS_BYTES, stream);
    if (e != hipSuccess) fprintf(stderr, "kernel_launch: cooperative launch failed: %s (grid %d)\n", hipGetErrorString(e), grid_blocks);
}
```
